# Optimizing an MI355X kernel written in HIP

```python
import math
import jax, jax.numpy as jnp
from jax import lax
import numpy as np

D_MODEL = 2048
BATCH = 4
SEQ = 4096
DEPTH = 2

N_MIXERS = 2
SB_HEADS = 16
SB_HEAD_DIM = D_MODEL // SB_HEADS
DA_HEADS = 8
DA_QK_DIM = D_MODEL // (2 * DA_HEADS)
DA_V_DIM = 2 * DA_QK_DIM
QBLK = 128
N_EXPERTS = 64
TOP_K = 6
N_GROUPS = 8
TOPK_GROUPS = 4
EXPERT_DIM = D_MODEL // 4
SHARED_DIM = EXPERT_DIM
ROUTED_SCALE = 2.5
MOE_BLK = 128
EPS = 1e-6
SUBLN_EPS = 1e-5

kernel_name = 'stickbreak_diffattn_moe_hybrid'


def rms_norm(x, g, eps=EPS):
    xf = x.astype(jnp.float32)
    y = xf * lax.rsqrt(jnp.mean(xf * xf, axis=-1, keepdims=True) + eps)
    return (y * g.astype(jnp.float32)).astype(x.dtype)


def _query_blocks(q):
    b, h, s = q.shape[:3]
    nb = s // QBLK
    qb = q.reshape((b, h, nb, QBLK) + q.shape[3:])
    return jnp.moveaxis(qb, 2, 0), nb


def _merge_blocks(out, b, h, s):
    return jnp.moveaxis(out, 0, 2).reshape(b, h, s, out.shape[-1])


def stick_breaking_attention(q, k, v):
    b, h, s, _ = q.shape
    scale = SB_HEAD_DIM ** -0.5
    qb, nb = _query_blocks(q)
    kpos = jnp.arange(s)

    def block(args):
        qi, bi = args
        z = jnp.einsum('bhqd,bhkd->bhqk', qi, k).astype(jnp.float32) * scale
        qpos = bi * QBLK + jnp.arange(QBLK)
        earlier = kpos[None, :] < qpos[:, None]
        log_keep = jnp.where(earlier, -jax.nn.softplus(z), 0.0)
        between = lax.cumsum(log_keep, axis=3, reverse=True) - log_keep
        a = jnp.where(earlier, jnp.exp(jax.nn.log_sigmoid(z) + between), 0.0)
        return jnp.einsum('bhqk,bhkd->bhqd', a.astype(v.dtype), v)

    out = lax.map(block, (qb, jnp.arange(nb)))
    return _merge_blocks(out, b, h, s)


def differential_attention(q, k, v, lam):
    b, h, s = q.shape[:3]
    scale = DA_QK_DIM ** -0.5
    slopes = jnp.asarray(2.0 ** (-8.0 * np.arange(1, DA_HEADS + 1) / DA_HEADS), jnp.float32)
    qb, nb = _query_blocks(q)
    kpos = jnp.arange(s)

    def block(args):
        qi, bi = args
        z = jnp.einsum('bhqcd,bhkcd->bchqk', qi, k).astype(jnp.float32) * scale
        qpos = bi * QBLK + jnp.arange(QBLK)
        dist = (qpos[:, None] - kpos[None, :]).astype(jnp.float32)
        z = jnp.where(dist >= 0, z - slopes[:, None, None] * dist, -jnp.inf)
        p = jax.nn.softmax(z, axis=-1)
        a = p[:, 0] - lam * p[:, 1]
        return jnp.einsum('bhqk,bhkd->bhqd', a.astype(v.dtype), v)

    out = lax.map(block, (qb, jnp.arange(nb)))
    return _merge_blocks(out, b, h, s)


def moe_ffn(h, w_router, router_bias, w_gate, w_up, w_down, ws_gate, ws_up, ws_down):
    t, d = h.shape
    scores = jax.nn.sigmoid((h @ w_router.T).astype(jnp.float32))
    biased = scores + router_bias.astype(jnp.float32)
    per_group = N_EXPERTS // N_GROUPS
    group_score = lax.top_k(biased.reshape(t, N_GROUPS, per_group), 2)[0].sum(-1)
    _, top_groups = lax.top_k(group_score, TOPK_GROUPS)
    group_keep = jax.nn.one_hot(top_groups, N_GROUPS).sum(1) > 0
    expert_keep = jnp.repeat(group_keep, per_group, axis=1)
    _, top_e = lax.top_k(jnp.where(expert_keep, biased, -jnp.inf), TOP_K)
    gate = jnp.take_along_axis(scores, top_e, axis=1)
    gate = gate / jnp.sum(gate, axis=-1, keepdims=True) * ROUTED_SCALE

    n_assign = t * TOP_K
    flat_e = top_e.reshape(-1)
    flat_tok = jnp.repeat(jnp.arange(t, dtype=jnp.int32), TOP_K)
    flat_w = gate.reshape(-1)
    order = jnp.argsort(flat_e)
    sorted_e = flat_e[order]
    counts = jnp.bincount(flat_e, length=N_EXPERTS)
    padded = (counts + MOE_BLK - 1) // MOE_BLK * MOE_BLK
    pad_end = jnp.cumsum(padded)
    pad_start = pad_end - padded
    start = jnp.cumsum(counts) - counts
    slot = pad_start[sorted_e] + jnp.arange(n_assign) - start[sorted_e]
    n_blocks = -(-n_assign // MOE_BLK) + N_EXPERTS
    n_slots = n_blocks * MOE_BLK
    slot_tok = jnp.zeros((n_slots,), jnp.int32).at[slot].set(flat_tok[order])
    slot_w = jnp.zeros((n_slots,), jnp.float32).at[slot].set(flat_w[order])
    block_e = jnp.minimum(
        jnp.searchsorted(pad_end, jnp.arange(n_blocks) * MOE_BLK, side='right'), N_EXPERTS - 1)

    def run_block(args):
        tok, wb, e = args
        xb = h[tok]
        yb = (jax.nn.silu(xb @ w_gate[e]) * (xb @ w_up[e])) @ w_down[e]
        return yb * wb[:, None].astype(yb.dtype)

    y = lax.map(run_block, (slot_tok.reshape(n_blocks, MOE_BLK),
                            slot_w.reshape(n_blocks, MOE_BLK), block_e)).reshape(n_slots, d)
    routed = jax.ops.segment_sum(y, slot_tok, num_segments=t)
    shared = (jax.nn.silu(h @ ws_gate) * (h @ ws_up)) @ ws_down
    return routed + shared


def setup_inputs(seed: int = 0) -> dict:
    key = jax.random.key(seed)
    ks = jax.random.split(key, 24)
    d, e, f = D_MODEL, N_EXPERTS, EXPERT_DIM
    n_da = DEPTH // N_MIXERS

    def normal(k, shape, scale=1.0):
        return jax.random.normal(k, shape, jnp.float32) * scale

    return {
        'x': normal(ks[0], (BATCH, SEQ, d)),
        'c': normal(ks[1], (BATCH, d)),
        'w_mod': normal(ks[2], (DEPTH, d, 6 * d), 0.5 * d ** -0.5),
        'b_mod': normal(ks[3], (DEPTH, 6 * d), 0.02),
        'norm_mix': 1.0 + normal(ks[4], (DEPTH, d), 0.02),
        'norm_ffn': 1.0 + normal(ks[5], (DEPTH, d), 0.02),
        'w_in': normal(ks[6], (DEPTH, d, 3 * d), d ** -0.5),
        'w_out': normal(ks[7], (DEPTH, d, d), d ** -0.5),
        'q_norm': 1.0 + normal(ks[8], (n_da, DA_QK_DIM), 0.02),
        'k_norm': 1.0 + normal(ks[9], (n_da, DA_QK_DIM), 0.02),
        'lambda_q1': normal(ks[10], (n_da, DA_QK_DIM), 0.1),
        'lambda_k1': normal(ks[11], (n_da, DA_QK_DIM), 0.1),
        'lambda_q2': normal(ks[12], (n_da, DA_QK_DIM), 0.1),
        'lambda_k2': normal(ks[13], (n_da, DA_QK_DIM), 0.1),
        'subln': 1.0 + normal(ks[14], (n_da, DA_V_DIM), 0.02),
        'w_router': normal(ks[15], (DEPTH, e, d), d ** -0.5),
        'router_bias': normal(ks[16], (DEPTH, e), 0.01),
        'w_gate': normal(ks[17], (DEPTH, e, d, f), d ** -0.5),
        'w_up': normal(ks[18], (DEPTH, e, d, f), d ** -0.5),
        'w_down': normal(ks[19], (DEPTH, e, f, d), f ** -0.5),
        'ws_gate': normal(ks[20], (DEPTH, d, SHARED_DIM), d ** -0.5),
        'ws_up': normal(ks[21], (DEPTH, d, SHARED_DIM), d ** -0.5),
        'ws_down': normal(ks[22], (DEPTH, SHARED_DIM, d), SHARED_DIM ** -0.5),
    }


def reference(x, c, w_mod, b_mod, norm_mix, norm_ffn, w_in, w_out, q_norm, k_norm,
              lambda_q1, lambda_k1, lambda_q2, lambda_k2, subln, w_router, router_bias,
              w_gate, w_up, w_down, ws_gate, ws_up, ws_down):
    b, s, d = x.shape
    cond = jax.nn.silu(c)
    for i in range(DEPTH):
        mod = cond @ w_mod[i] + b_mod[i]
        sh1, sc1, g1, sh2, sc2, g2 = jnp.split(mod[:, None, :], 6, axis=-1)
        h = rms_norm(x, norm_mix[i]) * (1 + sc1) + sh1
        q, k, v = jnp.split(h @ w_in[i], 3, axis=-1)
        if i % N_MIXERS == 0:
            def heads(t):
                return t.reshape(b, s, SB_HEADS, SB_HEAD_DIM).transpose(0, 2, 1, 3)
            o = stick_breaking_attention(heads(q), heads(k), heads(v))
        else:
            j = i // N_MIXERS
            lambda_init = 0.8 - 0.6 * math.exp(-0.3 * i)
            qh = rms_norm(q.reshape(b, s, DA_HEADS, 2, DA_QK_DIM), q_norm[j]).transpose(0, 2, 1, 3, 4)
            kh = rms_norm(k.reshape(b, s, DA_HEADS, 2, DA_QK_DIM), k_norm[j]).transpose(0, 2, 1, 3, 4)
            vh = v.reshape(b, s, DA_HEADS, DA_V_DIM).transpose(0, 2, 1, 3)
            lam = (jnp.exp(jnp.sum(lambda_q1[j].astype(jnp.float32) * lambda_k1[j].astype(jnp.float32)))
                   - jnp.exp(jnp.sum(lambda_q2[j].astype(jnp.float32) * lambda_k2[j].astype(jnp.float32)))
                   + lambda_init)
            o = differential_attention(qh, kh, vh, lam)
            o = rms_norm(o, subln[j], SUBLN_EPS) * (1.0 - lambda_init)
        o = o.transpose(0, 2, 1, 3).reshape(b, s, d)
        x = x + g1 * (o @ w_out[i])
        h = rms_norm(x, norm_ffn[i]) * (1 + sc2) + sh2
        y = moe_ffn(h.reshape(b * s, d), w_router[i], router_bias[i], w_gate[i], w_up[i],
                    w_down[i], ws_gate[i], ws_up[i], ws_down[i])
        x = x + g2 * y.reshape(b, s, d)
    return x
```

```cpp
#include <hip/hip_runtime.h>
#include <cstdio>
#include <cstdint>
#define ONE_LAUNCH 1
#define LAS __attribute__((address_space(3)))
#define GAS __attribute__((address_space(1)))
typedef unsigned short bf16_t;
typedef short bf16x8 __attribute__((ext_vector_type(8)));
typedef _Float16 f16x8 __attribute__((ext_vector_type(8)));
typedef float f32x4 __attribute__((ext_vector_type(4)));
typedef float f32x2 __attribute__((ext_vector_type(2)));
typedef float f32x16 __attribute__((ext_vector_type(16)));
typedef unsigned u32x4 __attribute__((ext_vector_type(4)));
typedef unsigned u32x2 __attribute__((ext_vector_type(2)));
typedef short s16x4 __attribute__((ext_vector_type(4)));
typedef int i32x8 __attribute__((ext_vector_type(8)));
typedef int i32x4 __attribute__((ext_vector_type(4)));

constexpr int D = 2048, NB = 4, S = 4096, T = NB * S, NE = 64, TOPK = 6, EF = 512;
constexpr int MODW = 6 * D;
constexpr int NSR = T * TOPK + NE * 256;
constexpr int NS = NSR + T;
constexpr int NRT_MAX = NS / 256;
constexpr float EPS = 1e-6f, SUBLN_EPS = 1e-5f;
constexpr float LOG2E = 1.4426950408889634f;
#ifndef DENSE1_FP8
#define DENSE1_FP8 1
#endif
constexpr float WD_SC = 64.f, O_SC = 4.f;
#ifndef DA_SWPIPE
#define DA_SWPIPE 0
#endif
#ifndef DENSE0_FP8
#define DENSE0_FP8 1
#endif
#ifndef DENSE0_QKV8
#define DENSE0_QKV8 DENSE0_FP8
#endif
#ifndef DENSE0_OUT8
#define DENSE0_OUT8 DENSE0_FP8
#endif

__device__ __forceinline__ unsigned cvt_pk_bf16(float lo, float hi) { unsigned r; asm volatile("v_cvt_pk_bf16_f32 %0, %1, %2" : "=v"(r) : "v"(lo), "v"(hi)); return r; }
__device__ __forceinline__ unsigned pk4_fp8(float a, float b, float c, float d) {
    a = __builtin_amdgcn_fmed3f(a, -448.f, 448.f); b = __builtin_amdgcn_fmed3f(b, -448.f, 448.f); c = __builtin_amdgcn_fmed3f(c, -448.f, 448.f); d = __builtin_amdgcn_fmed3f(d, -448.f, 448.f);
    int r = 0; r = __builtin_amdgcn_cvt_pk_fp8_f32(a, b, r, false); r = __builtin_amdgcn_cvt_pk_fp8_f32(c, d, r, true); return (unsigned)r; }
__device__ __forceinline__ float bf_lo(unsigned w) { return __uint_as_float(w << 16); }
__device__ __forceinline__ float bf_hi(unsigned w) { return __uint_as_float(w & 0xffff0000u); }
__device__ __forceinline__ float wave_sum(float v) {
#pragma unroll
    for (int o = 1; o < 64; o <<= 1) v += __shfl_xor(v, o);
    return v;
}

namespace pg8 {
constexpr int BM = 256, BK = 64, HALF = 128, HTB = HALF * BK * 2  , STAGE_BYTES = 8 * HTB, NXCD = 8, WGM = 8;
__host__ __device__ __forceinline__ int lds_byte(int r, int c) { const int st = (r >> 4) * 2 + (c >> 5), rr = r & 15, cc = c & 31, ob = rr * 64 + cc * 2; return st * 1024 + (ob ^ (((ob >> 9) & 1) << 5)); }
__host__ __device__ __forceinline__ void stage_rc(int b, int& R, int& C) { const int st = b / 1024, sb = b % 1024, swz = sb ^ (((sb >> 9) & 1) << 5); R = (st >> 1) * 16 + swz / 64; C = (st & 1) * 32 + (swz % 64) / 2; }
__host__ __device__ __forceinline__ int perm32(int rho) { const int n = rho >> 4, i = rho & 15; return 8 * (i >> 2) + 4 * n + (i & 3); }

struct Unit { int pm, pn, be; };
struct Gemm { const bf16_t* A; const bf16_t* Bt; int K; size_t bstride; const int* gather; int ld; size_t astride; };

struct StaticOrder {
    int nM, nN, nwg, G, c;
    __device__ void init(int M, int N, int G_, int c_) { nM = M / BM; nN = N / BM; nwg = nM * nN; G = G_; c = c_; }
    __device__ bool next(int i, Unit& u) const {
        const long L = (long)i * G + c; if (L >= nwg) return false;
        int wgid = (int)L; { const int q = nwg / NXCD, r = nwg % NXCD, xcd = wgid % NXCD, off = wgid / NXCD; wgid = (xcd < r ? xcd * (q + 1) : r * (q + 1) + (xcd - r) * q) + off; }
        const int nig = WGM * nN, gid = wgid / nig, fm = gid * WGM, gsz = (nM - fm) < WGM ? (nM - fm) : WGM;
        u.pm = fm + ((wgid % nig) % gsz); u.pn = (wgid % nig) / gsz; u.be = 0; return true;
    }
};
struct SplitOrder {
    int n, G, c;
    __device__ void init(int nM, int G_, int c_) { n = nM * 4; G = G_; c = c_; }
    __device__ bool next(int i, Unit& u) const { const int id = c + i * G; if (id >= n) return false; u.pm = id >> 2; u.be = id & 3; u.pn = 0; return true; }
};
struct MoeOrder {
    int npn, n, q, G8, x, j0, nrt, sbase, per;
    const LAS int* tile_e;
    __device__ void init(int ntiles, int npn_, int G, int c, const LAS int* te, int nrt_, int sbase_) { npn = npn_; n = ntiles * npn; q = (n + 7) / 8; G8 = G / 8; x = c % 8; j0 = c / 8; tile_e = te; nrt = nrt_; sbase = sbase_; per = (q + G8 - 1) / G8; }
    __device__ bool next(int i, Unit& u) const {
#ifdef MOE_CONTIG
        if (i >= per) return false; const int j = j0 * per + i; if (j >= q) return false; const int id = x * q + j; if (id >= n) return false;
#else
        const int j = j0 + i * G8; if (j >= q) return false; const int id = x * q + j; if (id >= n) return false;
#endif
        const int ct = id / npn; u.pn = id % npn; u.pm = ct < nrt ? ct : sbase + (ct - nrt); u.be = tile_e[u.pm]; return true;
    }
};

struct EpiBf16 {
    static constexpr int PERM = 2; static constexpr bool NOMMA = false; static constexpr int SEXP = 0, NSTORES = 16;
    bf16_t* O; int ldc; float sc;
    __device__ __forceinline__ void operator()(const f32x4 (&acc)[2][2][4][2], const Unit& u, int wr, int wc, int fr, int fq) const {
        const int row0 = u.pm * BM + wr * 64 + fr; const int col0 = u.pn * BM + wc * 64 + 16 * fq;
#pragma unroll
        for (int ai = 0; ai < 2; ++ai)
#pragma unroll
            for (int m = 0; m < 4; ++m) { bf16_t* rowp = O + (size_t)(row0 + ai * HALF + m * 16) * ldc + col0;
                const f32x4 v0 = acc[ai][0][m][0] * sc, v1 = acc[ai][0][m][1] * sc, v2 = acc[ai][1][m][0] * sc, v3 = acc[ai][1][m][1] * sc;
                u32x4 w0, w1; w0.x = cvt_pk_bf16(v0[0], v0[1]); w0.y = cvt_pk_bf16(v0[2], v0[3]); w0.z = cvt_pk_bf16(v1[0], v1[1]); w0.w = cvt_pk_bf16(v1[2], v1[3]);
                w1.x = cvt_pk_bf16(v2[0], v2[1]); w1.y = cvt_pk_bf16(v2[2], v2[3]); w1.z = cvt_pk_bf16(v3[0], v3[1]); w1.w = cvt_pk_bf16(v3[2], v3[3]);
                *(u32x4*)rowp = w0; *(u32x4*)(rowp + 8) = w1; }
    }
};
struct EpiBf16QK {
    static constexpr int PERM = 2; static constexpr bool NOMMA = false; static constexpr int SEXP = 0, NSTORES = 16;
    bf16_t* O; int ldc; const float* qn; const float* kn; LAS float* xch; float sc;
    __device__ __forceinline__ void operator()(const f32x4 (&acc)[2][2][4][2], const Unit& u, int wr, int wc, int fr, int fq) const {
        const int row0 = u.pm * BM + wr * 64 + fr; const int col0 = u.pn * BM + wc * 64 + 16 * fq;
        const bool qk = u.pn < 16;
        int fr_ = fr; asm volatile("" : "+v"(fr_));
        LAS float* xb = xch + (wr * 64 + fr_) * 4;
        if (qk) {
#pragma unroll
            for (int ai = 0; ai < 2; ++ai)
#pragma unroll
                for (int m = 0; m < 4; ++m) { float s_ = 0.f;
#pragma unroll
                    for (int q = 0; q < 4; ++q) { const f32x4 v = acc[ai][q >> 1][m][q & 1]; s_ += v[0] * v[0] + v[1] * v[1] + v[2] * v[2] + v[3] * v[3]; }
                    s_ += __shfl_xor(s_, 16); s_ += __shfl_xor(s_, 32);
                    if (fq == 0) xb[(ai * HALF + m * 16) * 4 + wc] = s_; }
            asm volatile("s_waitcnt lgkmcnt(0)" ::: "memory"); __builtin_amdgcn_s_barrier(); asm volatile("" ::: "memory");
        }
        f32x4 gw[4];
#pragma unroll
        for (int q = 0; q < 4; ++q) gw[q] = qk ? *(const f32x4*)((u.pn < 8 ? qn : kn) + (wc & 1) * 64 + 16 * fq + 4 * q) : (f32x4){1.f, 1.f, 1.f, 1.f};
#pragma unroll
        for (int ai = 0; ai < 2; ++ai)
#pragma unroll
            for (int m = 0; m < 4; ++m) { bf16_t* rowp = O + (size_t)(row0 + ai * HALF + m * 16) * ldc + col0; float r = sc;
                if (qk) { const LAS float* pp = xb + (ai * HALF + m * 16) * 4 + (wc & 2); r = rsqrtf((pp[0] + pp[1]) * (sc * sc * (1.f / 128.f)) + EPS) * sc; }
                const f32x4 v0 = acc[ai][0][m][0] * r * gw[0], v1 = acc[ai][0][m][1] * r * gw[1], v2 = acc[ai][1][m][0] * r * gw[2], v3 = acc[ai][1][m][1] * r * gw[3];
                u32x4 w0, w1; w0.x = cvt_pk_bf16(v0[0], v0[1]); w0.y = cvt_pk_bf16(v0[2], v0[3]); w0.z = cvt_pk_bf16(v1[0], v1[1]); w0.w = cvt_pk_bf16(v1[2], v1[3]);
                w1.x = cvt_pk_bf16(v2[0], v2[1]); w1.y = cvt_pk_bf16(v2[2], v2[3]); w1.z = cvt_pk_bf16(v3[0], v3[1]); w1.w = cvt_pk_bf16(v3[2], v3[3]);
                *(u32x4*)rowp = w0; *(u32x4*)(rowp + 8) = w1; }
    }
};
template <bool RBF> struct EpiResGate { static constexpr int SEXP = 0, NSTORES = 16;
    static constexpr int PERM = 2; static constexpr bool NOMMA = false;
    const void* R; bf16_t* out; const float* gate; float sc;
    __device__ __forceinline__ void operator()(const f32x4 (&acc)[2][2][4][2], const Unit& u, int wr, int wc, int fr, int fq) const {
        const int row0 = u.pm * BM + wr * 64 + fr, col0 = u.pn * BM + wc * 64 + 16 * fq;
        const float* gp = gate + (size_t)((u.pm * BM) / S) * MODW + col0;
        f32x4 gv[4];
#pragma unroll
        for (int q = 0; q < 4; ++q) gv[q] = *(const f32x4*)(gp + 4 * q) * sc;
#pragma unroll
        for (int ai = 0; ai < 2; ++ai)
#pragma unroll
            for (int m = 0; m < 4; ++m) { const size_t off = (size_t)(row0 + ai * HALF + m * 16) * D + col0; f32x4 r[4];
                if (RBF) { const u32x4 w0 = *(const u32x4*)((const bf16_t*)R + off), w1 = *(const u32x4*)((const bf16_t*)R + off + 8);
                    r[0] = (f32x4){bf_lo(w0.x), bf_hi(w0.x), bf_lo(w0.y), bf_hi(w0.y)}; r[1] = (f32x4){bf_lo(w0.z), bf_hi(w0.z), bf_lo(w0.w), bf_hi(w0.w)};
                    r[2] = (f32x4){bf_lo(w1.x), bf_hi(w1.x), bf_lo(w1.y), bf_hi(w1.y)}; r[3] = (f32x4){bf_lo(w1.z), bf_hi(w1.z), bf_lo(w1.w), bf_hi(w1.w)}; }
                else {
#pragma unroll
                    for (int q = 0; q < 4; ++q) r[q] = *(const f32x4*)((const float*)R + off + 4 * q); }
#pragma unroll
                for (int q = 0; q < 4; ++q) r[q] = r[q] + gv[q] * acc[ai][q >> 1][m][q & 1];
                u32x4 o0, o1; o0.x = cvt_pk_bf16(r[0][0], r[0][1]); o0.y = cvt_pk_bf16(r[0][2], r[0][3]); o0.z = cvt_pk_bf16(r[1][0], r[1][1]); o0.w = cvt_pk_bf16(r[1][2], r[1][3]);
                o1.x = cvt_pk_bf16(r[2][0], r[2][1]); o1.y = cvt_pk_bf16(r[2][2], r[2][3]); o1.z = cvt_pk_bf16(r[3][0], r[3][1]); o1.w = cvt_pk_bf16(r[3][2], r[3][3]);
                *(u32x4*)(out + off) = o0; *(u32x4*)(out + off + 8) = o1; }
    }
};
struct EpiRouter {
    static constexpr int PERM = 0; static constexpr bool NOMMA = false; static constexpr int SEXP = 0, NSTORES = 0;
    float* out;
    __device__ __forceinline__ void operator()(const f32x4 (&acc)[2][2][4][2], const Unit& u, int wr, int wc, int fr, int fq) const {
        if (wc >= 2) return;
        const int row0 = u.pm * BM + wr * 64 + fr, col0 = wc * 32 + 4 * fq;
#pragma unroll
        for (int ai = 0; ai < 2; ++ai)
#pragma unroll
            for (int m = 0; m < 4; ++m)
#pragma unroll
                for (int n = 0; n < 2; ++n) *(f32x4*)(out + ((size_t)u.be * T + row0 + ai * HALF + m * 16) * NE + col0 + n * 16) = acc[ai][0][m][n];
    }
};
__device__ __forceinline__ float silu_mul(float g, float u) { return g * u * __builtin_amdgcn_rcpf(1.f + __builtin_amdgcn_exp2f(-g * LOG2E)); }
struct EpiSwiGLU {
    static constexpr int PERM = 1; static constexpr bool NOMMA = false; static constexpr int SEXP = 0, NSTORES = 8;
    bf16_t* O;
    __device__ __forceinline__ void operator()(const f32x4 (&acc)[2][2][4][2], const Unit& u, int wr, int wc, int fr, int fq) const {
        const int row0 = u.pm * BM + wr * 64 + fr; const int col0 = u.pn * HALF + wc * 32 + 8 * fq;
#pragma unroll
        for (int ai = 0; ai < 2; ++ai)
#pragma unroll
            for (int m = 0; m < 4; ++m) { const f32x4 g0 = acc[ai][0][m][0], g1 = acc[ai][0][m][1], u0 = acc[ai][1][m][0], u1 = acc[ai][1][m][1];
                u32x4 w; w.x = cvt_pk_bf16(silu_mul(g0[0], u0[0]), silu_mul(g0[1], u0[1])); w.y = cvt_pk_bf16(silu_mul(g0[2], u0[2]), silu_mul(g0[3], u0[3]));
                w.z = cvt_pk_bf16(silu_mul(g1[0], u1[0]), silu_mul(g1[1], u1[1])); w.w = cvt_pk_bf16(silu_mul(g1[2], u1[2]), silu_mul(g1[3], u1[3]));
                *(u32x4*)(O + (size_t)(row0 + ai * HALF + m * 16) * EF + col0) = w; }
    }
};

struct EpiNull { static constexpr int PERM = 1; static constexpr bool NOMMA = false; __device__ __forceinline__ void operator()(const f32x4 (&acc)[2][2][4][2], const Unit& u, int wr, int wc, int fr, int fq) const {} };
struct EpiNullNoMma { static constexpr int PERM = 1; static constexpr bool NOMMA = true; static constexpr int SEXP = 0, NSTORES = 0; __device__ __forceinline__ void operator()(const f32x4 (&acc)[2][2][4][2], const Unit& u, int wr, int wc, int fr, int fq) const {} };
struct EpiFp8 {
    static constexpr int PERM = 2; static constexpr bool NOMMA = false; static constexpr int SEXP = -4, NSTORES = 8;
    unsigned char* O; int ldc; float sc;
    __device__ __forceinline__ void operator()(const f32x4 (&acc)[2][2][4][2], const Unit& u, int wr, int wc, int fr, int fq) const {
        const int row0 = u.pm * BM + wr * 64 + fr; const int col0 = u.pn * BM + wc * 64 + 16 * fq;
#pragma unroll
        for (int ai = 0; ai < 2; ++ai)
#pragma unroll
            for (int m = 0; m < 4; ++m) { const f32x4 v0 = acc[ai][0][m][0], v1 = acc[ai][0][m][1], v2 = acc[ai][1][m][0], v3 = acc[ai][1][m][1];
                u32x4 w; w.x = pk4_fp8(v0[0], v0[1], v0[2], v0[3]); w.y = pk4_fp8(v1[0], v1[1], v1[2], v1[3]); w.z = pk4_fp8(v2[0], v2[1], v2[2], v2[3]); w.w = pk4_fp8(v3[0], v3[1], v3[2], v3[3]);
                *(u32x4*)(O + (size_t)(row0 + ai * HALF + m * 16) * ldc + col0) = w; }
    }
};
struct EpiSwiGLU8 {
    static constexpr int PERM = 1; static constexpr bool NOMMA = false; static constexpr int SEXP = 0, NSTORES = 8;
    unsigned char* O; float isc, osc;
    __device__ __forceinline__ void operator()(const f32x4 (&acc)[2][2][4][2], const Unit& u, int wr, int wc, int fr, int fq) const {
        const int row0 = u.pm * BM + wr * 64 + fr; const int col0 = u.pn * HALF + wc * 32 + 8 * fq;
#pragma unroll
        for (int ai = 0; ai < 2; ++ai)
#pragma unroll
            for (int m = 0; m < 4; ++m) { const f32x4 g0 = acc[ai][0][m][0] * isc, g1 = acc[ai][0][m][1] * isc, u0 = acc[ai][1][m][0] * (isc * osc), u1 = acc[ai][1][m][1] * (isc * osc);
                u32x2 w; w.x = pk4_fp8(silu_mul(g0[0], u0[0]), silu_mul(g0[1], u0[1]), silu_mul(g0[2], u0[2]), silu_mul(g0[3], u0[3]));
                w.y = pk4_fp8(silu_mul(g1[0], u1[0]), silu_mul(g1[1], u1[1]), silu_mul(g1[2], u1[2]), silu_mul(g1[3], u1[3]));
                *(u32x2*)(O + (size_t)(row0 + ai * HALF + m * 16) * EF + col0) = w; }
    }
};

template <class Epi, class Sched, bool GATHER, bool FP8 = false>
__device__ __forceinline__ void gemm_phase(LAS unsigned char* lds, LAS int* idx, const Gemm g, const Sched& S, const Epi& E) {
    const int tid = threadIdx.x, wid = __builtin_amdgcn_readfirstlane(tid >> 6), lane = tid & 63, wr = wid >> 2, wc = wid & 3, fr = lane & 15, fq = lane >> 4;
    int K_ = g.K; asm volatile("" : "+s"(K_));
    const int K = K_, nt = K / BK; int LD_ = g.ld; asm volatile("" : "+s"(LD_)); const int LD = LD_;
    unsigned voffA[2], voffB[2];
#pragma unroll
    for (int i = 0; i < 2; ++i) { int R, C; stage_rc(tid * 16 + i * 8192, R, C); const int rho_ = R & 31;
        const int Rb = Epi::PERM == 1 ? ((R & ~31) + perm32(rho_)) : Epi::PERM == 2 ? ((R >> 5) * 64 + ((rho_ & 15) >> 2) * 16 + (rho_ >> 4) * 4 + (rho_ & 3)) : R;
        voffA[i] = (unsigned)(R * LD + C) * 2u; voffB[i] = (unsigned)(Rb * LD + C) * 2u; }
    const size_t kstep = (size_t)(BK * 2);
    const size_t hstep = (size_t)HALF * LD * 2;
    const size_t tstep = 2 * hstep;
    const size_t hstepB = Epi::PERM == 2 ? (size_t)8 * LD * 2 : hstep;
    const unsigned ldsw = (unsigned)wid * 1024u;
    const int aoff = lds_byte(wr * 64 + fr, fq * 8), boff = lds_byte(wc * 32 + fr, fq * 8);
    const unsigned rowB = (unsigned)LD * 2u;
#define PG8_SA(b, h) (((b) * 2 + (h)) * HTB)
#define PG8_SB(b, h) ((4 + (b) * 2 + (h)) * HTB)
#define PG8_STAGE(bufoff, gbase, voff) do { _Pragma("unroll") for (int _i = 0; _i < 2; ++_i) \
        __builtin_amdgcn_global_load_lds((const unsigned*)((const char*)(gbase) + (voff)[_i]), (LAS unsigned*)(lds + (bufoff) + ldsw + _i * 8192), 16, 0, 0); } while (0)
#define PG8_STAGEA(bufoff, h, ap, kb, go) do { if constexpr (GATHER) { PG8_STAGE(bufoff, (const char*)g.A + (kb), go[h]); } else { PG8_STAGE(bufoff, (ap) + (h) * hstep, voffA); } } while (0)
#define PG8_LD16(off) (*(const LAS i32x4*)(lds + (off)))
#define PG8_LDA(dst, b, h) do { if constexpr (FP8) { _Pragma("unroll") for (int m = 0; m < 4; ++m) dst##8[m] = __builtin_shufflevector(PG8_LD16(PG8_SA(b, h) + aoff + m * 2048), PG8_LD16(PG8_SA(b, h) + aoff + m * 2048 + 1024), 0, 1, 2, 3, 4, 5, 6, 7); } \
    else { _Pragma("unroll") for (int m = 0; m < 4; ++m) _Pragma("unroll") for (int k = 0; k < 2; ++k) dst[m][k] = *(const LAS bf16x8*)(lds + PG8_SA(b, h) + aoff + m * 2048 + k * 1024); } } while (0)
#define PG8_LDB(dst, b, h) do { if constexpr (FP8) { _Pragma("unroll") for (int n = 0; n < 2; ++n) dst##8[n] = __builtin_shufflevector(PG8_LD16(PG8_SB(b, h) + boff + n * 2048), PG8_LD16(PG8_SB(b, h) + boff + n * 2048 + 1024), 0, 1, 2, 3, 4, 5, 6, 7); } \
    else { _Pragma("unroll") for (int n = 0; n < 2; ++n) _Pragma("unroll") for (int k = 0; k < 2; ++k) dst[n][k] = *(const LAS bf16x8*)(lds + PG8_SB(b, h) + boff + n * 2048 + k * 1024); } } while (0)
#define PG8_MMA(ai, bj, At, Bt) do { if constexpr (Epi::NOMMA) { asm volatile("" :: "v"(At[0][0]), "v"(Bt[0][0]), "v"(At[3][1]), "v"(Bt[1][1])); break; } PG8_PRIO(1); if constexpr (FP8) { _Pragma("unroll") for (int m = 0; m < 4; ++m) _Pragma("unroll") for (int n = 0; n < 2; ++n) \
            asm volatile("v_mfma_scale_f32_16x16x128_f8f6f4 %0, %1, %2, %0, %3, %4 op_sel_hi:[0,0,0]" : "+v"(acc[ai][bj][m][n]) : "v"(Bt##8[n]), "v"(At##8[m]), "v"(one_scale), "v"(epi_scale)); } \
        else { _Pragma("unroll") for (int m = 0; m < 4; ++m) _Pragma("unroll") for (int n = 0; n < 2; ++n) _Pragma("unroll") for (int k = 0; k < 2; ++k) \
        acc[ai][bj][m][n] = __builtin_amdgcn_mfma_f32_16x16x32_bf16(Bt[n][k], At[m][k], acc[ai][bj][m][n], 0, 0, 0); } PG8_PRIO(0); } while (0)
#ifdef GEMM_STATIC_PRIO
#define PG8_PRIO(x) do {} while (0)
#else
#define PG8_PRIO(x) __builtin_amdgcn_s_setprio(x)
#endif
#define PG8_WAIT_V(n) asm volatile("s_waitcnt vmcnt(" #n ")" ::: "memory")
#define PG8_WAIT_L(n) asm volatile("s_waitcnt lgkmcnt(" #n ")" ::: "memory")
#define PG8_WAIT_V8R() do { if (relax) { if (GATHER && wid == 0 && has_next) asm volatile("s_waitcnt vmcnt(%0)" :: "n"(9 + Epi::NSTORES) : "memory"); else asm volatile("s_waitcnt vmcnt(%0)" :: "n"(8 + Epi::NSTORES) : "memory"); } else PG8_WAIT_V(8); } while (0)
#define PG8_BAR __builtin_amdgcn_s_barrier()
#define PG8_SCHED __builtin_amdgcn_sched_barrier(0)
    Unit cur, nxt; int ui = 0;
    if (!S.next(0, cur)) return;
#ifdef GEMM_STATIC_PRIO
    if (wr == 1) __builtin_amdgcn_s_setprio(1);
#endif
    f32x4 acc[2][2][4][2];
#pragma unroll
    for (int a = 0; a < 2; ++a)
#pragma unroll
        for (int b = 0; b < 2; ++b)
#pragma unroll
            for (int m = 0; m < 4; ++m)
#pragma unroll
                for (int n = 0; n < 2; ++n) acc[a][b][m][n] = (f32x4){0.f, 0.f, 0.f, 0.f};
    bf16x8 At[4][2], B0[2][2], B1[2][2]; i32x8 At8[4], B08[2], B18[2];
    const unsigned epi_scale = 0x01010101u * (unsigned)(127 + Epi::SEXP);
    const unsigned one_scale = 0x7f7f7f7fu;
    const char* cA = (const char*)g.A + (GATHER ? (size_t)0 : (size_t)cur.pm * tstep + (size_t)cur.be * g.astride);
    const char* cB = (const char*)g.Bt + (size_t)cur.be * g.bstride + (size_t)cur.pn * tstep;
    unsigned gc[2][2] = {{0u, 0u}, {0u, 0u}};
#define PG8_GIDX(dst, base) do { _Pragma("unroll") for (int i = 0; i < 2; ++i) { int R_, C_; stage_rc(tid * 16 + i * 8192, R_, C_); _Pragma("unroll") for (int h = 0; h < 2; ++h) dst[h][i] = (unsigned)idx[(base) + h * HALF + R_] * rowB + (unsigned)C_ * 2u; } } while (0)
    if constexpr (GATHER) {
        if (wid == 0) __builtin_amdgcn_global_load_lds((const unsigned*)(g.gather + (size_t)cur.pm * BM + lane * 4), (LAS unsigned*)idx, 16, 0, 0);
        PG8_WAIT_V(0); PG8_BAR;
        PG8_GIDX(gc, 0);
        PG8_WAIT_L(0); PG8_BAR;
    }
    PG8_STAGE(PG8_SB(0, 0), cB, voffB); PG8_STAGE(PG8_SB(0, 1), cB + hstepB, voffB); PG8_STAGEA(PG8_SA(0, 0), 0, cA, 0, gc); PG8_STAGEA(PG8_SA(0, 1), 1, cA, 0, gc);
    if (wr == 1) PG8_BAR;
    PG8_WAIT_V(2); PG8_BAR;
    PG8_STAGE(PG8_SB(1, 0), cB + kstep, voffB); PG8_STAGEA(PG8_SA(1, 0), 0, cA + kstep, kstep, gc); PG8_STAGE(PG8_SB(1, 1), cB + hstepB + kstep, voffB);
    PG8_WAIT_V(6); PG8_BAR;
    for (;;) {
        const bool has_next = S.next(ui + 1, nxt);
        const char* nA = (has_next && !GATHER) ? (const char*)g.A + (size_t)nxt.pm * tstep + (size_t)nxt.be * g.astride : cA;
        const char* nB = has_next ? (const char*)g.Bt + (size_t)nxt.be * g.bstride + (size_t)nxt.pn * tstep : cB;
        if constexpr (GATHER) {
            if (has_next && wid == 0) __builtin_amdgcn_global_load_lds((const unsigned*)(g.gather + (size_t)nxt.pm * BM + lane * 4), (LAS unsigned*)(idx + ((ui + 1) & 1) * BM), 16, 0, 0);
        }
        int t = 0;
        do {
            const bool last = (t == nt - 2);
            const char* a1 = cA + (size_t)(t + 1) * kstep;
            const char* a2 = last ? nA : cA + (size_t)(t + 2) * kstep; const char* b2 = last ? nB : cB + (size_t)(t + 2) * kstep;
            const char* a3 = a2 + kstep; const char* b3 = b2 + kstep;
            const size_t k1 = (size_t)(t + 1) * kstep, k2 = last ? (size_t)0 : (size_t)(t + 2) * kstep, k3 = k2 + kstep;
            unsigned g2[2][2];
#pragma unroll
            for (int h = 0; h < 2; ++h)
#pragma unroll
                for (int i = 0; i < 2; ++i) g2[h][i] = gc[h][i];
            if constexpr (GATHER) { if (last && has_next) PG8_GIDX(g2, ((ui + 1) & 1) * BM); }
            const int relax = __builtin_amdgcn_readfirstlane(((t == 0) && (ui > 0)) ? 1 : 0);
            PG8_LDB(B0, 0, 0); PG8_LDB(B1, 0, 1); PG8_SCHED; PG8_LDA(At, 0, 0); PG8_STAGEA(PG8_SA(1, 1), 1, a1, k1, gc);
            PG8_WAIT_V8R(); PG8_WAIT_L(0); PG8_BAR; PG8_MMA(0, 0, At, B0); PG8_MMA(0, 1, At, B1); PG8_BAR; PG8_SCHED;
            PG8_LDA(At, 0, 1); PG8_STAGE(PG8_SB(0, 0), b2, voffB); PG8_STAGE(PG8_SB(0, 1), b2 + hstepB, voffB); PG8_STAGEA(PG8_SA(0, 0), 0, a2, k2, g2);
            PG8_WAIT_V8R(); PG8_WAIT_L(0); PG8_BAR; PG8_MMA(1, 0, At, B0); PG8_MMA(1, 1, At, B1); PG8_BAR; PG8_SCHED;
            PG8_LDB(B0, 1, 0); PG8_LDB(B1, 1, 1); PG8_SCHED; PG8_LDA(At, 1, 0); PG8_STAGEA(PG8_SA(0, 1), 1, a2, k2, g2);
            PG8_WAIT_V(8); PG8_WAIT_L(0); PG8_BAR; PG8_MMA(0, 0, At, B0); PG8_MMA(0, 1, At, B1); PG8_BAR; PG8_SCHED;
            PG8_LDA(At, 1, 1); PG8_STAGE(PG8_SB(1, 0), b3, voffB); PG8_STAGE(PG8_SB(1, 1), b3 + hstepB, voffB); PG8_STAGEA(PG8_SA(1, 0), 0, a3, k3, g2);
            PG8_WAIT_V(8); PG8_WAIT_L(0); PG8_BAR; PG8_MMA(1, 0, At, B0); PG8_MMA(1, 1, At, B1); PG8_BAR; PG8_SCHED;
            if constexpr (GATHER) { if (last) { _Pragma("unroll") for (int h = 0; h < 2; ++h) _Pragma("unroll") for (int i = 0; i < 2; ++i) gc[h][i] = g2[h][i]; } }
            t += 2;
        } while (t < nt);
        if (wr == 0) PG8_BAR;
        if constexpr (FP8) asm volatile("s_nop 15\n\ts_nop 7" ::: "memory");
        E(acc, cur, wr, wc, fr, fq);
#ifdef PROBE_EPI2
        E(acc, cur, wr, wc, fr, fq);
#endif
        if (!has_next) break;
#pragma unroll
        for (int a = 0; a < 2; ++a)
#pragma unroll
            for (int b = 0; b < 2; ++b)
#pragma unroll
                for (int m = 0; m < 4; ++m)
#pragma unroll
                    for (int n = 0; n < 2; ++n) acc[a][b][m][n] = (f32x4){0.f, 0.f, 0.f, 0.f};
        cur = nxt; cA = nA; cB = nB; ++ui;
        if (wr == 1) PG8_BAR;
    }
    PG8_WAIT_V(0);
    PG8_BAR;
#ifdef GEMM_STATIC_PRIO
    __builtin_amdgcn_s_setprio(0);
#endif
#undef PG8_SA
#undef PG8_SB
#undef PG8_STAGE
#undef PG8_STAGEA
#undef PG8_GIDX
#undef PG8_LD16
#undef PG8_LDA
#undef PG8_LDB
#undef PG8_MMA
#undef PG8_PRIO
#undef PG8_WAIT_V
#undef PG8_WAIT_V8R
#undef PG8_WAIT_L
#undef PG8_BAR
#undef PG8_SCHED
}
}
namespace att {
constexpr int LDQ = 3 * D;
constexpr int KVBLK = 64, SHM_T = KVBLK * 128 * 2;
constexpr int L_V = 0, L_K = 2 * SHM_T, L_WS = 4 * SHM_T, L_FLAG = L_WS + 8 * 64 * 4, ATT_LDS = L_FLAG + 64;
constexpr float QK_C = 0.08838834764831845f * LOG2E;
#define KSWZ(row, colB) ((row) * 256 + ((colB) ^ (((row) & 7) << 4)))
#define SBAR() __builtin_amdgcn_sched_barrier(0)
__device__ __forceinline__ int crow(int r, int hi) { return (r & 3) + 8 * (r >> 2) + 4 * hi; }
__device__ __forceinline__ int v_st(int k, int c) { const int kk = (k & ~0xC) | ((k & 4) << 1) | ((k & 8) >> 1); return ((kk >> 3) * 4 + (c >> 5)) * 512 + ((kk & 7) * 32 + (c & 31)) * 2; }
__device__ __forceinline__ int v_rd_base(int lane) { return ((lane & 3) << 3) | (((lane >> 2) & 3) << 6) | (((lane >> 4) & 1) << 5) | (((lane >> 5) & 1) << 8); }
constexpr int v_rd_off(int d0, int ks, int half) { return d0 * 512 + ks * 4096 + half * 2048; }
template <int OFF> __device__ __forceinline__ s16x4 tr_read(int vb) { s16x4 r; asm volatile("ds_read_b64_tr_b16 %0, %1 offset:%2" : "=&v"(r) : "v"(vb), "i"(OFF) : "memory"); return r; }
template <int D0> __device__ __forceinline__ void pv_one(f32x16& od, int vb, bf16x8 pa0, bf16x8 pa1, bf16x8 pa2, bf16x8 pa3) {
#define PK(L, H) (bf16x8){L[0], L[1], L[2], L[3], H[0], H[1], H[2], H[3]}
    { const s16x4 l0 = tr_read<v_rd_off(D0, 0, 0)>(vb), h0 = tr_read<v_rd_off(D0, 0, 1)>(vb), l1 = tr_read<v_rd_off(D0, 1, 0)>(vb), h1 = tr_read<v_rd_off(D0, 1, 1)>(vb);
      asm volatile("s_waitcnt lgkmcnt(0)" ::: "memory"); SBAR();
      od = __builtin_amdgcn_mfma_f32_32x32x16_bf16(pa0, PK(l0, h0), od, 0, 0, 0);
      od = __builtin_amdgcn_mfma_f32_32x32x16_bf16(pa1, PK(l1, h1), od, 0, 0, 0); }
    { const s16x4 l2 = tr_read<v_rd_off(D0, 2, 0)>(vb), h2 = tr_read<v_rd_off(D0, 2, 1)>(vb), l3 = tr_read<v_rd_off(D0, 3, 0)>(vb), h3 = tr_read<v_rd_off(D0, 3, 1)>(vb);
      asm volatile("s_waitcnt lgkmcnt(0)" ::: "memory"); SBAR();
      od = __builtin_amdgcn_mfma_f32_32x32x16_bf16(pa2, PK(l2, h2), od, 0, 0, 0);
      od = __builtin_amdgcn_mfma_f32_32x32x16_bf16(pa3, PK(l3, h3), od, 0, 0, 0); }
#undef PK
}
template <int D0, int KS> __device__ __forceinline__ void pv_half(f32x16& od, int vb, bf16x8 paA, bf16x8 paB) {
#define PK(L, H) (bf16x8){L[0], L[1], L[2], L[3], H[0], H[1], H[2], H[3]}
    const s16x4 l0 = tr_read<v_rd_off(D0, KS, 0)>(vb), h0 = tr_read<v_rd_off(D0, KS, 1)>(vb), l1 = tr_read<v_rd_off(D0, KS + 1, 0)>(vb), h1 = tr_read<v_rd_off(D0, KS + 1, 1)>(vb);
    asm volatile("s_waitcnt lgkmcnt(0)" ::: "memory"); SBAR();
    od = __builtin_amdgcn_mfma_f32_32x32x16_bf16(paA, PK(l0, h0), od, 0, 0, 0);
    od = __builtin_amdgcn_mfma_f32_32x32x16_bf16(paB, PK(l1, h1), od, 0, 0, 0); SBAR();
#undef PK
}
__device__ __forceinline__ void qkt(f32x16& p0, f32x16& p1, const LAS char* Ks, const bf16x8* qr, int r32, int hi) {
    p0 = f32x16{}; p1 = f32x16{};
#pragma unroll
    for (int d0 = 0; d0 < 8; ++d0) { const int cb = (d0 * 16 + hi * 8) * 2;
        const bf16x8 b0 = *(const LAS bf16x8*)(Ks + KSWZ(r32, cb));
        const bf16x8 b1 = *(const LAS bf16x8*)(Ks + KSWZ(32 + r32, cb));
        p0 = __builtin_amdgcn_mfma_f32_32x32x16_bf16(b0, qr[d0], p0, 0, 0, 0);
        p1 = __builtin_amdgcn_mfma_f32_32x32x16_bf16(b1, qr[d0], p1, 0, 0, 0); }
}
#define PK4BF(P, BASE, OUT) do { unsigned a0 = cvt_pk_bf16(P[BASE + 0], P[BASE + 1]), a1 = cvt_pk_bf16(P[BASE + 2], P[BASE + 3]);   \
    unsigned b0 = cvt_pk_bf16(P[BASE + 4], P[BASE + 5]), b1 = cvt_pk_bf16(P[BASE + 6], P[BASE + 7]);                              \
    auto r0 = __builtin_amdgcn_permlane32_swap(a0, b0, false, false); auto r1 = __builtin_amdgcn_permlane32_swap(a1, b1, false, false); \
    u32x4 w = {r0[0], r1[0], r0[1], r1[1]}; OUT = __builtin_bit_cast(bf16x8, w); } while (0)
__device__ __forceinline__ unsigned pk_f16(float lo, float hi) { return __builtin_bit_cast(unsigned, __builtin_amdgcn_cvt_pkrtz(lo, hi)); }
#define PK4H(P, BASE, OUT) do { unsigned a0 = pk_f16(P[BASE + 0], P[BASE + 1]), a1 = pk_f16(P[BASE + 2], P[BASE + 3]);   \
    unsigned b0 = pk_f16(P[BASE + 4], P[BASE + 5]), b1 = pk_f16(P[BASE + 6], P[BASE + 7]);                              \
    auto r0 = __builtin_amdgcn_permlane32_swap(a0, b0, false, false); auto r1 = __builtin_amdgcn_permlane32_swap(a1, b1, false, false); \
    u32x4 w = {r0[0], r1[0], r0[1], r1[1]}; OUT = __builtin_bit_cast(f16x8, w); } while (0)
__device__ __forceinline__ float xhalf_sum(float v) { auto rr = __builtin_amdgcn_permlane32_swap(__float_as_uint(v), __float_as_uint(v), false, false); return __uint_as_float(rr[0]) + __uint_as_float(rr[1]); }
__device__ __forceinline__ float xhalf_max(float v) { auto rr = __builtin_amdgcn_permlane32_swap(__float_as_uint(v), __float_as_uint(v), false, false); return fmaxf(__uint_as_float(rr[0]), __uint_as_float(rr[1])); }

struct AttnArgs { const bf16_t* QKV; bf16_t* O; int ldo; };
template <int MODE>
__device__ __forceinline__ void attn_unit(const AttnArgs& A, int b, int qb, int qc, int kc, int vc, int oc, float slope2, int dmax, LAS char* lds) {
    const int tid = threadIdx.x, lane = tid & 63, r32 = lane & 31, hi = lane >> 5; const int wid = __builtin_amdgcn_readfirstlane(tid >> 6);
    const size_t rowb = (size_t)b * S; const int q0 = qb * 256, r0 = q0 + wid * 32;
    const bf16_t* Kg = A.QKV + rowb * LDQ + kc; const bf16_t* Vg = A.QKV + rowb * LDQ + vc;
    LAS float* ws = (LAS float*)(lds + L_WS) + wid * 64; LAS unsigned* flags = (LAS unsigned*)(lds + L_FLAG);
    bf16x8 qr[8];
    { const bf16_t* Qw = A.QKV + (rowb + r0 + r32) * LDQ + qc + hi * 8;
#pragma unroll
      for (int d0 = 0; d0 < 8; ++d0) qr[d0] = *(const bf16x8*)(Qw + d0 * 16); }
    f32x16 o[4]; o[0] = f32x16{}; o[1] = f32x16{}; o[2] = f32x16{}; o[3] = f32x16{};
    const int vb0 = (int)(uintptr_t)(lds + L_V) + v_rd_base(lane);
    const int tq = r0 + r32;
    unsigned koff[2], voff[2];
#pragma unroll
    for (int i = 0; i < 2; ++i) { const int row = 4 * wid + (lane >> 4) + 32 * i, cb = ((lane & 15) * 16) ^ ((row & 7) << 4); koff[i] = (unsigned)(row * LDQ + cb / 2);
        const int st = 2 * wid + 16 * i + (lane >> 5), kk = 8 * (st >> 2) + ((lane & 31) >> 2), key = (kk & ~0xC) | ((kk & 4) << 1) | ((kk & 8) >> 1), col = 32 * (st & 3) + (lane & 3) * 8; voff[i] = (unsigned)(key * LDQ + col); }
#define DMA_TILE(k0, bf) do { _Pragma("unroll") for (int _i = 0; _i < 2; ++_i) { \
        __builtin_amdgcn_global_load_lds((const unsigned*)(Kg + (size_t)(k0) * LDQ + koff[_i]), (LAS unsigned*)(lds + L_K + (bf) * SHM_T + wid * 1024 + _i * 8192), 16, 0, 0); \
        __builtin_amdgcn_global_load_lds((const unsigned*)(Vg + (size_t)(k0) * LDQ + voff[_i]), (LAS unsigned*)(lds + L_V + (bf) * SHM_T + wid * 1024 + _i * 8192), 16, 0, 0); } } while (0)
    const int NT = 4 * (qb + 1);
    int kt_lo = 0; if (MODE == 1) { const int lim = q0 - 63 - dmax; kt_lo = lim > 0 ? (lim + 63) / 64 : 0; }
    const int NIT = NT - kt_lo;
    if (tid < 16) flags[tid] = 0u;
    DMA_TILE((NT - 1) * KVBLK, 0);
    float carry = 0.f, m_run = -1e30f, l_run = 0.f; bool wdone = false;
    f16x8 tri0, tri1, ones;
#pragma unroll
    for (int i = 0; i < 8; ++i) { tri0[i] = (8 * hi + i > r32) ? (_Float16)1.0f : (_Float16)0.0f; tri1[i] = (16 + 8 * hi + i > r32) ? (_Float16)1.0f : (_Float16)0.0f; ones[i] = (_Float16)1.0f; }
    for (int it = 0; it < NIT; ++it) {
        const int k0 = (NT - 1 - it) * KVBLK, bf = it & 1;
        asm volatile("s_waitcnt vmcnt(0)" ::: "memory");
        __syncthreads();
        if (MODE == 0) { const u32x4 fa = *(const LAS u32x4*)(flags + ((it + 1) & 1) * 8), fb = *(const LAS u32x4*)(flags + ((it + 1) & 1) * 8 + 4);
            if (it > 0 && (fa.x & fa.y & fa.z & fa.w & fb.x & fb.y & fb.z & fb.w) != 0u) break; }
        if (it + 1 < NIT) DMA_TILE((NT - 2 - it) * KVBLK, bf ^ 1);
        const bool active = (k0 <= r0) && !wdone && (MODE == 0 || k0 + 63 + dmax >= r0);
        if (active) {
            f32x16 p0, p1;
            qkt(p0, p1, lds + L_K + bf * SHM_T, qr, r32, hi);
            const int vb = vb0 + bf * SHM_T;
            bf16x8 pa0, pa1, pa2, pa3;
            if (MODE == 0) {
                const bool need_mask = (k0 + 63 >= r0);
                float lsum = 0.f;
                float lk0[16], lk1[16];
#pragma unroll
                for (int r = 0; r < 16; ++r) {
                    { const float zl = p0[r] * QK_C, u = __builtin_amdgcn_exp2f(-fabsf(zl)), L = __builtin_amdgcn_logf(1.f + u), sp = fmaxf(zl, 0.f) + L;
                      const bool ok = !need_mask || (k0 + crow(r, hi) < tq); lk0[r] = ok ? -sp : 0.f; p0[r] = ok ? (zl - sp) : -INFINITY; lsum += lk0[r]; }
                    { const float zl = p1[r] * QK_C, u = __builtin_amdgcn_exp2f(-fabsf(zl)), L = __builtin_amdgcn_logf(1.f + u), sp = fmaxf(zl, 0.f) + L;
                      const bool ok = !need_mask || (k0 + 32 + crow(r, hi) < tq); lk1[r] = ok ? -sp : 0.f; p1[r] = ok ? (zl - sp) : -INFINITY; lsum += lk1[r]; }
                }
                f16x8 f0, f1, f2, f3; PK4H(lk0, 0, f0); PK4H(lk0, 8, f1); PK4H(lk1, 0, f2); PK4H(lk1, 8, f3);
                f32x16 w0, w1;
#pragma unroll
                for (int r = 0; r < 16; ++r) { w0[r] = carry; w1[r] = carry; }
                w0 = __builtin_amdgcn_mfma_f32_32x32x16_f16(tri0, f0, w0, 0, 0, 0); w0 = __builtin_amdgcn_mfma_f32_32x32x16_f16(tri1, f1, w0, 0, 0, 0);
                w0 = __builtin_amdgcn_mfma_f32_32x32x16_f16(ones, f2, w0, 0, 0, 0); w0 = __builtin_amdgcn_mfma_f32_32x32x16_f16(ones, f3, w0, 0, 0, 0);
                w1 = __builtin_amdgcn_mfma_f32_32x32x16_f16(tri0, f2, w1, 0, 0, 0); w1 = __builtin_amdgcn_mfma_f32_32x32x16_f16(tri1, f3, w1, 0, 0, 0);
#pragma unroll
                for (int r = 0; r < 16; ++r) { p0[r] = __builtin_amdgcn_exp2f(p0[r] + w0[r]); p1[r] = __builtin_amdgcn_exp2f(p1[r] + w1[r]); }
                carry += xhalf_sum(lsum);
                wdone = __all(carry < -150.f);
            } else {
                const bool need_mask = (k0 + 63 > r0);
                const float fb = (float)(k0 - tq + 4 * hi);
                float mx = -1e30f;
#pragma unroll
                for (int r = 0; r < 16; ++r) { const float t0 = fb + (float)((r & 3) + 8 * (r >> 2)), t1 = t0 + 32.f;
                    float z0 = fmaf(slope2, t0, p0[r] * QK_C), z1 = fmaf(slope2, t1, p1[r] * QK_C);
                    if (need_mask) { if (t0 > 0.f) z0 = -INFINITY; if (t1 > 0.f) z1 = -INFINITY; }
                    p0[r] = z0; p1[r] = z1; mx = fmaxf(mx, fmaxf(z0, z1)); }
                mx = xhalf_max(mx);
                const float mn = fmaxf(m_run, mx), alpha = __builtin_amdgcn_exp2f(m_run - mn); m_run = mn;
                float ps = 0.f;
#pragma unroll
                for (int r = 0; r < 16; ++r) { p0[r] = __builtin_amdgcn_exp2f(p0[r] - mn); p1[r] = __builtin_amdgcn_exp2f(p1[r] - mn); ps += p0[r] + p1[r]; }
                l_run = l_run * alpha + xhalf_sum(ps);
                if (__any(alpha < 1.f)) { if (hi == 0) ws[r32] = alpha; asm volatile("s_waitcnt lgkmcnt(0)" ::: "memory");
#pragma unroll
                    for (int r = 0; r < 16; ++r) { const float a_ = ws[crow(r, hi)];
#pragma unroll
                        for (int d = 0; d < 4; ++d) o[d][r] *= a_; } }
            }
            PK4BF(p0, 0, pa0); PK4BF(p0, 8, pa1); PK4BF(p1, 0, pa2); PK4BF(p1, 8, pa3);
            SBAR();
            {
              s16x4 aL0, aH0, aL1, aH1, bL0, bH0, bL1, bH1;
#define PVRD(S, D0, KS) do { S##L0 = tr_read<v_rd_off(D0, KS, 0)>(vb); S##H0 = tr_read<v_rd_off(D0, KS, 1)>(vb); S##L1 = tr_read<v_rd_off(D0, KS + 1, 0)>(vb); S##H1 = tr_read<v_rd_off(D0, KS + 1, 1)>(vb); } while (0)
#define PVMM(S, OD, PA, PB, WAITN) do { asm volatile("s_waitcnt lgkmcnt(" #WAITN ")" ::: "memory"); SBAR(); \
        OD = __builtin_amdgcn_mfma_f32_32x32x16_bf16(PA, ((bf16x8){S##L0[0], S##L0[1], S##L0[2], S##L0[3], S##H0[0], S##H0[1], S##H0[2], S##H0[3]}), OD, 0, 0, 0); \
        OD = __builtin_amdgcn_mfma_f32_32x32x16_bf16(PB, ((bf16x8){S##L1[0], S##L1[1], S##L1[2], S##L1[3], S##H1[0], S##H1[1], S##H1[2], S##H1[3]}), OD, 0, 0, 0); SBAR(); } while (0)
              PVRD(a, 0, 0);
              PVRD(b, 1, 0); PVMM(a, o[0], pa0, pa1, 4); PVRD(a, 2, 0); PVMM(b, o[1], pa0, pa1, 4);
              PVRD(b, 3, 0); PVMM(a, o[2], pa0, pa1, 4); PVRD(a, 0, 2); PVMM(b, o[3], pa0, pa1, 4);
              PVRD(b, 1, 2); PVMM(a, o[0], pa2, pa3, 4); PVRD(a, 2, 2); PVMM(b, o[1], pa2, pa3, 4);
              PVRD(b, 3, 2); PVMM(a, o[2], pa2, pa3, 4);                PVMM(b, o[3], pa2, pa3, 0);
#undef PVRD
#undef PVMM
            }
        }
        if (MODE == 0 && lane == 0) flags[bf * 8 + wid] = wdone ? 1u : 0u;
    }
    __syncthreads();
    float rli[16];
    if (MODE == 1) { if (hi == 0) ws[32 + r32] = l_run; asm volatile("s_waitcnt lgkmcnt(0)" ::: "memory");
#pragma unroll
        for (int r = 0; r < 16; ++r) rli[r] = __builtin_amdgcn_rcpf(ws[32 + crow(r, hi)]); }
    else {
#pragma unroll
        for (int r = 0; r < 16; ++r) rli[r] = 1.f; }
#if DENSE0_OUT8
    if (MODE == 0) {
        LAS unsigned char* stg8 = (LAS unsigned char*)(lds + wid * 8192);
#pragma unroll
        for (int r = 0; r < 16; ++r) { const int orow = crow(r, hi);
#pragma unroll
            for (int d0 = 0; d0 < 4; ++d0) stg8[orow * 128 + d0 * 32 + r32] = (unsigned char)(pk4_fp8(o[d0][r] * O_SC, 0.f, 0.f, 0.f) & 0xffu); }
        asm volatile("s_waitcnt lgkmcnt(0)" ::: "memory");
        unsigned char* Ow8 = (unsigned char*)A.O + (rowb + r0) * (size_t)A.ldo + oc;
#pragma unroll
        for (int i = 0; i < 4; ++i) { const int row = i * 8 + (lane >> 3), ch = lane & 7; const u32x4 v = *(const LAS u32x4*)(stg8 + row * 128 + ch * 16); *(u32x4*)(Ow8 + (size_t)row * A.ldo + ch * 16) = v; }
    } else
#endif
    {
    LAS bf16_t* stg = (LAS bf16_t*)(lds + wid * 8192);
#pragma unroll
    for (int r = 0; r < 16; ++r) { const int orow = crow(r, hi);
#pragma unroll
        for (int d0 = 0; d0 < 4; ++d0) stg[orow * 128 + d0 * 32 + r32] = (bf16_t)(cvt_pk_bf16(o[d0][r] * rli[r], 0.f) & 0xffffu); }
    asm volatile("s_waitcnt lgkmcnt(0)" ::: "memory");
    bf16_t* Ow = A.O + (rowb + r0) * (size_t)A.ldo + oc;
#pragma unroll
    for (int i = 0; i < 8; ++i) { const int row = i * 4 + (lane >> 4), ch = lane & 15; const u32x4 v = *(const LAS u32x4*)(stg + row * 128 + ch * 8); *(u32x4*)(Ow + (size_t)row * A.ldo + ch * 8) = v; }
    }
    __syncthreads();
#undef DMA_TILE
}

__device__ __forceinline__ void attn_unit_da(const bf16_t* QKV, bf16_t* O, int b, int h, int qb, float slope2, int dmax, bool freeze_ok, const float* const* in, float lambda_init, LAS char* lds) {
    const int tid = threadIdx.x, lane = tid & 63, r32 = lane & 31, hi = lane >> 5; const int wid = __builtin_amdgcn_readfirstlane(tid >> 6);
    const int rg = wid & 3, c = wid >> 2;
    const size_t rowb = (size_t)b * S; const int q0 = qb * 128, r0 = q0 + rg * 32;
    const bf16_t* Kg0 = QKV + rowb * LDQ + D + h * 256; const bf16_t* Vg = QKV + rowb * LDQ + 2 * D + h * 256;
    constexpr int STG = 4 * SHM_T;
    LAS float* ws = (LAS float*)(lds + 2 * STG) + wid * 64;
    bf16x8 qr[8];
    { const bf16_t* Qw = QKV + (rowb + r0 + r32) * LDQ + h * 256 + c * 128 + hi * 8;
#pragma unroll
      for (int d0 = 0; d0 < 8; ++d0) { const u32x4 w = *(const u32x4*)(Qw + d0 * 16);
          u32x4 o_; o_.x = cvt_pk_bf16(bf_lo(w.x) * QK_C, bf_hi(w.x) * QK_C); o_.y = cvt_pk_bf16(bf_lo(w.y) * QK_C, bf_hi(w.y) * QK_C); o_.z = cvt_pk_bf16(bf_lo(w.z) * QK_C, bf_hi(w.z) * QK_C); o_.w = cvt_pk_bf16(bf_lo(w.w) * QK_C, bf_hi(w.w) * QK_C);
          qr[d0] = __builtin_bit_cast(bf16x8, o_); } }
    f32x16 o[8];
#pragma unroll
    for (int d = 0; d < 8; ++d) o[d] = f32x16{};
    const int vb0 = (int)(uintptr_t)(lds + 2 * SHM_T) + v_rd_base(lane);
#if DA_SWPIPE
#define DMA_OFFS() int ln_ = lane; asm volatile("" : "+v"(ln_)); unsigned koff[2], voff[2]; _Pragma("unroll") for (int i = 0; i < 2; ++i) { const int row = 4 * wid + (ln_ >> 4) + 32 * i, cb = ((ln_ & 15) * 16) ^ ((row & 7) << 4); koff[i] = (unsigned)(row * LDQ + cb / 2); \
        const int st = 2 * wid + 16 * i + (ln_ >> 5), kk_ = 8 * (st >> 2) + ((ln_ & 31) >> 2), key = (kk_ & ~0xC) | ((kk_ & 4) << 1) | ((kk_ & 8) >> 1), col = 32 * (st & 3) + (ln_ & 3) * 8; voff[i] = (unsigned)(key * LDQ + col); }
#define DMA_K(kk) do { DMA_OFFS(); const size_t kr_ = (size_t)((NT - 1 - (kk)) * KVBLK) * LDQ; _Pragma("unroll") for (int _i = 0; _i < 2; ++_i) { \
        __builtin_amdgcn_global_load_lds((const unsigned*)(Kg0 + kr_ + koff[_i]), (LAS unsigned*)(lds + ((kk) & 1) * STG + wid * 1024 + _i * 8192), 16, 0, 0); \
        __builtin_amdgcn_global_load_lds((const unsigned*)(Kg0 + kr_ + koff[_i] + 128), (LAS unsigned*)(lds + ((kk) & 1) * STG + SHM_T + wid * 1024 + _i * 8192), 16, 0, 0); } } while (0)
#define DMA_V(kk) do { DMA_OFFS(); const size_t kr_ = (size_t)((NT - 1 - (kk)) * KVBLK) * LDQ; _Pragma("unroll") for (int _i = 0; _i < 2; ++_i) { \
        __builtin_amdgcn_global_load_lds((const unsigned*)(Vg + kr_ + voff[_i]), (LAS unsigned*)(lds + ((kk) & 1) * STG + 2 * SHM_T + wid * 1024 + _i * 8192), 16, 0, 0); \
        __builtin_amdgcn_global_load_lds((const unsigned*)(Vg + kr_ + voff[_i] + 128), (LAS unsigned*)(lds + ((kk) & 1) * STG + 3 * SHM_T + wid * 1024 + _i * 8192), 16, 0, 0); } } while (0)
    const int NT = 2 * (qb + 1);
    int kt_lo = 0; { const int lim = q0 - 63 - dmax; kt_lo = lim > 0 ? (lim + 63) / 64 : 0; }
    const int NIT = NT - kt_lo;
    float m_run = -1e30f, l_run = 0.f;
    f32x16 p0, p1; bf16x8 pa0, pa1, pa2, pa3;
#define ACT(kk) ((kk) >= 0 && (kk) < NIT && (NT - 1 - (kk)) * KVBLK <= r0 && (NT - 1 - (kk)) * KVBLK + 63 + dmax >= r0)
#define PVRD(S, D0, KS, VBH) do { S##L0 = tr_read<v_rd_off(D0, KS, 0)>(VBH); S##H0 = tr_read<v_rd_off(D0, KS, 1)>(VBH); S##L1 = tr_read<v_rd_off(D0, KS + 1, 0)>(VBH); S##H1 = tr_read<v_rd_off(D0, KS + 1, 1)>(VBH); } while (0)
#define PVMM(S, OD, PA, PB, WAITN) do { asm volatile("s_waitcnt lgkmcnt(" #WAITN ")" ::: "memory"); SBAR(); \
        OD = __builtin_amdgcn_mfma_f32_32x32x16_bf16(PA, ((bf16x8){S##L0[0], S##L0[1], S##L0[2], S##L0[3], S##H0[0], S##H0[1], S##H0[2], S##H0[3]}), OD, 0, 0, 0); \
        OD = __builtin_amdgcn_mfma_f32_32x32x16_bf16(PB, ((bf16x8){S##L1[0], S##L1[1], S##L1[2], S##L1[3], S##H1[0], S##H1[1], S##H1[2], S##H1[3]}), OD, 0, 0, 0); SBAR(); } while (0)
#define QKRD(S, KB, OFF) do { S##0 = *(const LAS bf16x8*)((KB) + (OFF)); S##1 = *(const LAS bf16x8*)((KB) + (OFF) + 8192); } while (0)
#define QKMM(S, QI, WAITN) do { asm volatile("s_waitcnt lgkmcnt(" #WAITN ")" ::: "memory"); SBAR(); \
        p0 = __builtin_amdgcn_mfma_f32_32x32x16_bf16(S##0, qr[QI], p0, 0, 0, 0); p1 = __builtin_amdgcn_mfma_f32_32x32x16_bf16(S##1, qr[QI], p1, 0, 0, 0); SBAR(); } while (0)
#define MPART(kk) do { \
        if (ACT((kk) - 1)) { const int vb = vb0 + (((kk) - 1) & 1) * STG; s16x4 aL0, aH0, aL1, aH1, bL0, bH0, bL1, bH1; \
            PVRD(a, 0, 0, vb); \
            PVRD(b, 1, 0, vb);         PVMM(a, o[0], pa0, pa1, 4); PVRD(a, 2, 0, vb);         PVMM(b, o[1], pa0, pa1, 4); \
            PVRD(b, 3, 0, vb);         PVMM(a, o[2], pa0, pa1, 4); PVRD(a, 0, 0, vb + SHM_T); PVMM(b, o[3], pa0, pa1, 4); \
            PVRD(b, 1, 0, vb + SHM_T); PVMM(a, o[4], pa0, pa1, 4); PVRD(a, 2, 0, vb + SHM_T); PVMM(b, o[5], pa0, pa1, 4); \
            PVRD(b, 3, 0, vb + SHM_T); PVMM(a, o[6], pa0, pa1, 4); PVRD(a, 0, 2, vb);         PVMM(b, o[7], pa0, pa1, 4); \
            PVRD(b, 1, 2, vb);         PVMM(a, o[0], pa2, pa3, 4); PVRD(a, 2, 2, vb);         PVMM(b, o[1], pa2, pa3, 4); \
            PVRD(b, 3, 2, vb);         PVMM(a, o[2], pa2, pa3, 4); PVRD(a, 0, 2, vb + SHM_T); PVMM(b, o[3], pa2, pa3, 4); \
            PVRD(b, 1, 2, vb + SHM_T); PVMM(a, o[4], pa2, pa3, 4); PVRD(a, 2, 2, vb + SHM_T); PVMM(b, o[5], pa2, pa3, 4); \
            PVRD(b, 3, 2, vb + SHM_T); PVMM(a, o[6], pa2, pa3, 4); PVMM(b, o[7], pa2, pa3, 0); } \
        if (ACT(kk)) { const int k0 = (NT - 1 - (kk)) * KVBLK; int lt_ = lane; asm volatile("" : "+v"(lt_)); const int hi_t = lt_ >> 5, r32_t = lt_ & 31; \
            const float cb = slope2 * (float)(k0 - r0 + 4 * hi_t); float sl_ = slope2; asm volatile("" : "+v"(sl_)); \
            _Pragma("unroll") for (int r = 0; r < 16; ++r) { p0[r] = fmaf(sl_, (float)((r & 3) + 8 * (r >> 2)), cb); p1[r] = fmaf(sl_, (float)(32 + (r & 3) + 8 * (r >> 2)), cb); } \
            const LAS char* Ks = lds + ((kk) & 1) * STG + c * SHM_T; \
            const LAS char* kb0 = Ks + (r32_t * 256 + (((0 * 2 + hi_t) ^ (r32_t & 7)) << 4)); const LAS char* kb1 = Ks + (r32_t * 256 + (((1 * 2 + hi_t) ^ (r32_t & 7)) << 4)); \
            const LAS char* kb2 = Ks + (r32_t * 256 + (((2 * 2 + hi_t) ^ (r32_t & 7)) << 4)); const LAS char* kb3 = Ks + (r32_t * 256 + (((3 * 2 + hi_t) ^ (r32_t & 7)) << 4)); \
            bf16x8 xa0, xa1, xb0, xb1; \
            QKRD(xa, kb0, 0); QKRD(xb, kb0, 128); QKMM(xa, 0, 2); QKRD(xa, kb1, 0); QKMM(xb, 4, 2); QKRD(xb, kb1, 128); QKMM(xa, 1, 2); QKRD(xa, kb2, 0); QKMM(xb, 5, 2); \
            QKRD(xb, kb2, 128); QKMM(xa, 2, 2); QKRD(xa, kb3, 0); QKMM(xb, 6, 2); QKRD(xb, kb3, 128); QKMM(xa, 3, 2); QKMM(xb, 7, 0); } } while (0)
#define VPART(kk) do { if (ACT(kk)) { const int k0 = (NT - 1 - (kk)) * KVBLK; int lt_ = lane; asm volatile("" : "+v"(lt_)); const int hi_t = lt_ >> 5, r32_t = lt_ & 31; \
            float mx = -1e30f; \
            if (k0 + 63 > r0) { const int kq = k0 - (r0 + r32_t) + 4 * hi_t; \
                _Pragma("unroll") for (int r = 0; r < 16; ++r) { const int kr = kq + (r & 3) + 8 * (r >> 2); if (kr > 0) p0[r] = -INFINITY; if (kr + 32 > 0) p1[r] = -INFINITY; } } \
            _Pragma("unroll") for (int r = 0; r < 16; ++r) mx = fmaxf(mx, fmaxf(p0[r], p1[r])); \
            mx = xhalf_max(mx); \
            const float mn = fmaxf(m_run, mx), alpha = __builtin_amdgcn_exp2f(m_run - mn); m_run = mn; \
            float ps = 0.f; \
            _Pragma("unroll") for (int r = 0; r < 16; ++r) { p0[r] = __builtin_amdgcn_exp2f(p0[r] - mn); p1[r] = __builtin_amdgcn_exp2f(p1[r] - mn); ps += p0[r] + p1[r]; } \
            l_run = l_run * alpha + xhalf_sum(ps); \
            if (__any(alpha < 1.f)) { LAS float* ws_t = (LAS float*)(lds + 2 * STG) + wid * 64; if (hi_t == 0) ws_t[r32_t] = alpha; asm volatile("s_waitcnt lgkmcnt(0)" ::: "memory"); const LAS float* wa_t = ws_t + 4 * hi_t; \
                _Pragma("unroll") for (int r = 0; r < 16; ++r) { const float a_ = wa_t[(r & 3) + 8 * (r >> 2)]; _Pragma("unroll") for (int d = 0; d < 8; ++d) o[d][r] *= a_; } } \
            PK4BF(p0, 0, pa0); PK4BF(p0, 8, pa1); PK4BF(p1, 0, pa2); PK4BF(p1, 8, pa3); } } while (0)
#define SLOT_BAR() do { asm volatile("s_waitcnt vmcnt(0)" ::: "memory"); __syncthreads(); } while (0)
#define DMA_STEP(kk) do { if ((kk) + 1 < NIT) DMA_K((kk) + 1); if ((kk) >= 1 && (kk) < NIT) DMA_V(kk); } while (0)
    DMA_K(0); DMA_V(0);
    if (c == 1) { SLOT_BAR(); DMA_STEP(0); }
    for (int k = 0; k <= NIT; ++k) {
        SLOT_BAR(); if (c == 0) DMA_STEP(k);
        MPART(k);
        SLOT_BAR(); if (c == 1) DMA_STEP(k + 1);
        VPART(k);
    }
    if (c == 0) SLOT_BAR();
#undef DMA_STEP
#undef DMA_OFFS
#undef DMA_K
#undef DMA_V
#undef ACT
#undef PVRD
#undef PVMM
#undef QKRD
#undef QKMM
#undef MPART
#undef VPART
#undef SLOT_BAR
#else
#define DMA_DA(k0, bf) do { int ln_ = lane; asm volatile("" : "+v"(ln_)); unsigned koff[2], voff[2]; _Pragma("unroll") for (int i = 0; i < 2; ++i) { const int row = 4 * wid + (ln_ >> 4) + 32 * i, cb = ((ln_ & 15) * 16) ^ ((row & 7) << 4); koff[i] = (unsigned)(row * LDQ + cb / 2); \
        const int st = 2 * wid + 16 * i + (ln_ >> 5), kk = 8 * (st >> 2) + ((ln_ & 31) >> 2), key = (kk & ~0xC) | ((kk & 4) << 1) | ((kk & 8) >> 1), col = 32 * (st & 3) + (ln_ & 3) * 8; voff[i] = (unsigned)(key * LDQ + col); } \
    _Pragma("unroll") for (int _i = 0; _i < 2; ++_i) { \
        __builtin_amdgcn_global_load_lds((const unsigned*)(Kg0 + (size_t)(k0) * LDQ + koff[_i]), (LAS unsigned*)(lds + (bf) * STG + wid * 1024 + _i * 8192), 16, 0, 0); \
        __builtin_amdgcn_global_load_lds((const unsigned*)(Kg0 + (size_t)(k0) * LDQ + koff[_i] + 128), (LAS unsigned*)(lds + (bf) * STG + SHM_T + wid * 1024 + _i * 8192), 16, 0, 0); \
        __builtin_amdgcn_global_load_lds((const unsigned*)(Vg + (size_t)(k0) * LDQ + voff[_i]), (LAS unsigned*)(lds + (bf) * STG + 2 * SHM_T + wid * 1024 + _i * 8192), 16, 0, 0); \
        __builtin_amdgcn_global_load_lds((const unsigned*)(Vg + (size_t)(k0) * LDQ + voff[_i] + 128), (LAS unsigned*)(lds + (bf) * STG + 3 * SHM_T + wid * 1024 + _i * 8192), 16, 0, 0); } } while (0)
    const int NT = 2 * (qb + 1);
    int kt_lo = 0; { const int lim = q0 - 63 - dmax; kt_lo = lim > 0 ? (lim + 63) / 64 : 0; }
    const int NIT = NT - kt_lo;
    DMA_DA((NT - 1) * KVBLK, 0);
    float m_run = -1e30f, l_run = 0.f;
    for (int it = 0; it < NIT; ++it) {
        const int k0 = (NT - 1 - it) * KVBLK, bf = it & 1;
        asm volatile("s_waitcnt vmcnt(0)" ::: "memory");
        __syncthreads();
        if (it + 1 < NIT) DMA_DA((NT - 2 - it) * KVBLK, bf ^ 1);
        const bool active = (k0 <= r0) && (k0 + 63 + dmax >= r0);
        if (active) {
            int lt_ = lane; asm volatile("" : "+v"(lt_)); const int hi_t = lt_ >> 5, r32_t = lt_ & 31;
            const float fb = slope2 * (float)(k0 - r0 + 4 * hi_t);
            const bool need_mask = (k0 + 63 > r0);
            const float cb = fb;
            f32x16 p0, p1; float sl_ = slope2; asm volatile("" : "+v"(sl_));
#pragma unroll
            for (int r = 0; r < 16; ++r) { p0[r] = fmaf(sl_, (float)((r & 3) + 8 * (r >> 2)), cb); p1[r] = fmaf(sl_, (float)(32 + (r & 3) + 8 * (r >> 2)), cb); }
            {
              const LAS char* Ks = lds + bf * STG + c * SHM_T; int ln_ = lane; asm volatile("" : "+v"(ln_)); const int r32_ = ln_ & 31, hi_ = ln_ >> 5;
              const LAS char* kb0 = Ks + (r32_ * 256 + (((0 * 2 + hi_) ^ (r32_ & 7)) << 4)); const LAS char* kb1 = Ks + (r32_ * 256 + (((1 * 2 + hi_) ^ (r32_ & 7)) << 4));
              const LAS char* kb2 = Ks + (r32_ * 256 + (((2 * 2 + hi_) ^ (r32_ & 7)) << 4)); const LAS char* kb3 = Ks + (r32_ * 256 + (((3 * 2 + hi_) ^ (r32_ & 7)) << 4));
              bf16x8 xa0, xa1, xb0, xb1;
#define QKRD(S, KB, OFF) do { S##0 = *(const LAS bf16x8*)((KB) + (OFF)); S##1 = *(const LAS bf16x8*)((KB) + (OFF) + 8192); } while (0)
#define QKMM(S, QI, WAITN) do { asm volatile("s_waitcnt lgkmcnt(" #WAITN ")" ::: "memory"); SBAR(); \
        p0 = __builtin_amdgcn_mfma_f32_32x32x16_bf16(S##0, qr[QI], p0, 0, 0, 0); p1 = __builtin_amdgcn_mfma_f32_32x32x16_bf16(S##1, qr[QI], p1, 0, 0, 0); SBAR(); } while (0)
              QKRD(xa, kb0, 0);
              QKRD(xb, kb0, 128); QKMM(xa, 0, 2);
              QKRD(xa, kb1, 0);   QKMM(xb, 4, 2);
              QKRD(xb, kb1, 128); QKMM(xa, 1, 2);
              QKRD(xa, kb2, 0);   QKMM(xb, 5, 2);
              QKRD(xb, kb2, 128); QKMM(xa, 2, 2);
              QKRD(xa, kb3, 0);   QKMM(xb, 6, 2);
              QKRD(xb, kb3, 128); QKMM(xa, 3, 2);
                                  QKMM(xb, 7, 0);
#undef QKRD
#undef QKMM
            }
            {
                float mx = -1e30f;
                if (need_mask) { const int kq = k0 - (r0 + r32_t) + 4 * hi_t;
#pragma unroll
                    for (int r = 0; r < 16; ++r) { const int kr = kq + (r & 3) + 8 * (r >> 2); if (kr > 0) p0[r] = -INFINITY; if (kr + 32 > 0) p1[r] = -INFINITY; } }
#pragma unroll
                for (int r = 0; r < 16; ++r) mx = fmaxf(mx, fmaxf(p0[r], p1[r]));
                mx = xhalf_max(mx);
                const float mn = fmaxf(m_run, mx), alpha = __builtin_amdgcn_exp2f(m_run - mn); m_run = mn;
                float ps = 0.f;
#pragma unroll
                for (int r = 0; r < 16; ++r) { p0[r] = __builtin_amdgcn_exp2f(p0[r] - mn); p1[r] = __builtin_amdgcn_exp2f(p1[r] - mn); ps += p0[r] + p1[r]; }
                l_run = l_run * alpha + xhalf_sum(ps);
                if (__any(alpha < 1.f)) { LAS float* ws_t = (LAS float*)(lds + 2 * STG) + wid * 64; if (hi_t == 0) ws_t[r32_t] = alpha; asm volatile("s_waitcnt lgkmcnt(0)" ::: "memory"); const LAS float* wa_t = ws_t + 4 * hi_t;
#pragma unroll
                    for (int r = 0; r < 16; ++r) { const float a_ = wa_t[(r & 3) + 8 * (r >> 2)];
#pragma unroll
                        for (int d = 0; d < 8; ++d) o[d][r] *= a_; } }
            }
            const int vb = vb0 + bf * STG;
            bf16x8 pa0, pa1, pa2, pa3; PK4BF(p0, 0, pa0); PK4BF(p0, 8, pa1); PK4BF(p1, 0, pa2); PK4BF(p1, 8, pa3); SBAR();
            s16x4 aL0, aH0, aL1, aH1, bL0, bH0, bL1, bH1;
#define PVRD(S, D0, KS, VBH) do { S##L0 = tr_read<v_rd_off(D0, KS, 0)>(VBH); S##H0 = tr_read<v_rd_off(D0, KS, 1)>(VBH); S##L1 = tr_read<v_rd_off(D0, KS + 1, 0)>(VBH); S##H1 = tr_read<v_rd_off(D0, KS + 1, 1)>(VBH); } while (0)
#define PVMM(S, OD, PA, PB, WAITN) do { asm volatile("s_waitcnt lgkmcnt(" #WAITN ")" ::: "memory"); SBAR(); \
        OD = __builtin_amdgcn_mfma_f32_32x32x16_bf16(PA, ((bf16x8){S##L0[0], S##L0[1], S##L0[2], S##L0[3], S##H0[0], S##H0[1], S##H0[2], S##H0[3]}), OD, 0, 0, 0); \
        OD = __builtin_amdgcn_mfma_f32_32x32x16_bf16(PB, ((bf16x8){S##L1[0], S##L1[1], S##L1[2], S##L1[3], S##H1[0], S##H1[1], S##H1[2], S##H1[3]}), OD, 0, 0, 0); SBAR(); } while (0)
            PVRD(a, 0, 0, vb);
            PVRD(b, 1, 0, vb);         PVMM(a, o[0], pa0, pa1, 4);
            PVRD(a, 2, 0, vb);         PVMM(b, o[1], pa0, pa1, 4);
            PVRD(b, 3, 0, vb);         PVMM(a, o[2], pa0, pa1, 4);
            PVRD(a, 0, 0, vb + SHM_T); PVMM(b, o[3], pa0, pa1, 4);
            PVRD(b, 1, 0, vb + SHM_T); PVMM(a, o[4], pa0, pa1, 4);
            PVRD(a, 2, 0, vb + SHM_T); PVMM(b, o[5], pa0, pa1, 4);
            PVRD(b, 3, 0, vb + SHM_T); PVMM(a, o[6], pa0, pa1, 4);
            PVRD(a, 0, 2, vb);         PVMM(b, o[7], pa0, pa1, 4);
            PVRD(b, 1, 2, vb);         PVMM(a, o[0], pa2, pa3, 4);
            PVRD(a, 2, 2, vb);         PVMM(b, o[1], pa2, pa3, 4);
            PVRD(b, 3, 2, vb);         PVMM(a, o[2], pa2, pa3, 4);
            PVRD(a, 0, 2, vb + SHM_T); PVMM(b, o[3], pa2, pa3, 4);
            PVRD(b, 1, 2, vb + SHM_T); PVMM(a, o[4], pa2, pa3, 4);
            PVRD(a, 2, 2, vb + SHM_T); PVMM(b, o[5], pa2, pa3, 4);
            PVRD(b, 3, 2, vb + SHM_T); PVMM(a, o[6], pa2, pa3, 4);
                                       PVMM(b, o[7], pa2, pa3, 0);
#undef PVRD
#undef PVMM
        }
    }
#endif
    __syncthreads();
    int hi_e = hi, r32_e = r32, lane_e = lane; asm volatile("" : "+v"(hi_e), "+v"(r32_e), "+v"(lane_e));
    { if (hi_e == 0) ws[32 + r32_e] = l_run; asm volatile("s_waitcnt lgkmcnt(0)" ::: "memory");
      const LAS float* wl = ws + 32 + 4 * hi_e;
#pragma unroll
      for (int r = 0; r < 16; ++r) { const float rl = __builtin_amdgcn_rcpf(wl[(r & 3) + 8 * (r >> 2)]);
#pragma unroll
          for (int d = 0; d < 8; ++d) o[d][r] *= rl; } }
    LAS float* slab = (LAS float*)(lds + rg * 32768) + lane_e;
    if (c == 1) {
#pragma unroll
        for (int d = 0; d < 8; ++d)
#pragma unroll
            for (int r = 0; r < 16; ++r) slab[(d * 16 + r) * 64] = o[d][r];
    }
    __syncthreads();
    if (c == 0) {
        float s1 = in[10][lane_e] * in[11][lane_e] + in[10][lane_e + 64] * in[11][lane_e + 64], s2 = in[12][lane_e] * in[13][lane_e] + in[12][lane_e + 64] * in[13][lane_e + 64];
        s1 = wave_sum(s1); s2 = wave_sum(s2);
        const float lam = __expf(s1) - __expf(s2) + lambda_init, out_scale = 1.f - lambda_init; const float* subln = in[14];
        float ssq[16];
#pragma unroll
        for (int r = 0; r < 16; ++r) ssq[r] = 0.f;
#pragma unroll
        for (int d = 0; d < 8; ++d)
#pragma unroll
            for (int r = 0; r < 16; ++r) { const float v = o[d][r] - lam * slab[(d * 16 + r) * 64]; o[d][r] = v; ssq[r] += v * v; }
#pragma unroll
        for (int r = 0; r < 16; ++r) { float s_ = ssq[r]; s_ += __shfl_xor(s_, 1); s_ += __shfl_xor(s_, 2); s_ += __shfl_xor(s_, 4); s_ += __shfl_xor(s_, 8); s_ += __shfl_xor(s_, 16);
            ssq[r] = rsqrtf(s_ * (1.f / 256.f) + SUBLN_EPS) * out_scale; }
        asm volatile("s_waitcnt lgkmcnt(0)" ::: "memory");
#if DENSE1_FP8
        LAS unsigned char* stg = (LAS unsigned char*)(lds + rg * 32768);
        LAS unsigned char* stw = stg + hi_e * 1024 + r32_e;
#pragma unroll
        for (int d = 0; d < 8; ++d) { const float g = subln[d * 32 + r32_e] * O_SC;
#pragma unroll
            for (int r = 0; r < 16; ++r) stw[((r & 3) + 8 * (r >> 2)) * 256 + d * 32] = (unsigned char)(pk4_fp8(o[d][r] * ssq[r] * g, 0.f, 0.f, 0.f) & 0xffu); }
        asm volatile("s_waitcnt lgkmcnt(0)" ::: "memory");
        unsigned char* Ow = (unsigned char*)O + (rowb + r0 + (lane_e >> 4)) * (size_t)D + h * 256 + (lane_e & 15) * 16;
        const LAS unsigned char* str_ = stg + (lane_e >> 4) * 256 + (lane_e & 15) * 16;
#pragma unroll
        for (int i = 0; i < 8; ++i) { const u32x4 v = *(const LAS u32x4*)(str_ + i * 1024); *(u32x4*)(Ow + (size_t)i * 4 * D) = v; }
#else
        LAS bf16_t* stg = (LAS bf16_t*)(lds + rg * 32768);
        LAS bf16_t* stw = stg + hi_e * 1024 + r32_e;
#pragma unroll
        for (int d = 0; d < 8; ++d) { const float g = subln[d * 32 + r32_e];
#pragma unroll
            for (int r = 0; r < 16; ++r) stw[((r & 3) + 8 * (r >> 2)) * 256 + d * 32] = (bf16_t)(cvt_pk_bf16(o[d][r] * ssq[r] * g, 0.f) & 0xffffu); }
        asm volatile("s_waitcnt lgkmcnt(0)" ::: "memory");
        bf16_t* Ow = O + (rowb + r0 + (lane_e >> 5)) * (size_t)D + h * 256 + (lane_e & 31) * 8;
        const LAS bf16_t* str_ = stg + (lane_e >> 5) * 256 + (lane_e & 31) * 8;
#pragma unroll
        for (int i = 0; i < 16; ++i) { const u32x4 v = *(const LAS u32x4*)(str_ + i * 512); *(u32x4*)(Ow + (size_t)i * 2 * D) = v; }
#endif
    }
    __syncthreads();
#if !DA_SWPIPE
#undef DMA_DA
#endif
}
}
constexpr int NWAVES = 8, NTHREADS = 512;
constexpr size_t MiB = 1u << 20;
constexpr int RING_BYTES = 133120;
constexpr int TAB_OFF = RING_BYTES;
constexpr int TAB_IDX = TAB_OFF, TAB_TILE = TAB_OFF + 2048, TAB_MISC = TAB_TILE + 2048, TAB_END = TAB_MISC + 1024;
constexpr int MISC_OFF = TAB_END;
constexpr int EPI_OFF = 139264;
constexpr int LDS_BYTES = 147456;
static_assert(MISC_OFF + 128 <= EPI_OFF && EPI_OFF + 8192 <= LDS_BYTES, "LDS map");
constexpr size_t WS_CTL = 0, CTL_ZERO_BYTES = 1 * MiB;
constexpr size_t WS_TOK = WS_CTL + CTL_ZERO_BYTES;
constexpr size_t ZERO_BYTES = CTL_ZERO_BYTES + (size_t)NS * 4;
constexpr size_t WS_MOD = 2 * MiB;
constexpr size_t WS_LOGIT = 340 * MiB;
constexpr size_t WS_TOPE = 7 * MiB, WS_GATE = 8 * MiB, WS_LPOS = 9 * MiB, WS_SLOT = 10 * MiB;
constexpr size_t WS_CNT = 11 * MiB;
constexpr size_t WS_TILEE = 11 * MiB + 128 * 1024;
constexpr size_t WS_WIN = 12 * MiB;
constexpr size_t WS_WOUT = 60 * MiB;
constexpr size_t WS_WR = 76 * MiB;
#ifndef MOE_FP8
#define MOE_FP8 1
#endif
constexpr float W1_SC = 64.f, W2_SC = 32.f, ACT_SC = 4.f, Y_SC = 8.f;
constexpr size_t WS_WIN8 = 12 * MiB + 24 * MiB, WS_WOUT8 = 60 * MiB + 8 * MiB;
constexpr size_t WS_W1 = 78 * MiB;
constexpr size_t WS_W2 = 598 * MiB;
constexpr size_t WS_XN8 = 730 * MiB;
constexpr size_t WS_XA = 858 * MiB;
constexpr size_t WS_XB = 922 * MiB;
constexpr size_t WS_XN = 986 * MiB;
constexpr size_t WS_ACT = 1050 * MiB;
constexpr size_t WS_R = 1178 * MiB;
constexpr size_t WS_QKV = WS_R, WS_O = WS_R + 192 * MiB, WS_OT = WS_R + 256 * MiB, WS_Y = WS_R;
constexpr size_t WS_END = WS_R + 512 * MiB;
constexpr int CW_TMO = 0, CW_BAR = 4096;

#define XB_TMO      128
#define XB_XCNT(j)  (256  + 64 * (j))
#define XB_XSUB(j)  (1280 + 64 * (j))
#define XB_XGEN(j)  (2304 + 64 * (j))
#define XB_TOP      3328
#define XB_TOPGEN   3392
#define XCD_BAR_WORDS 3456
#define XB_SPIN_CAP (1u << 18)
__device__ __forceinline__ unsigned xb_ld(unsigned* p)              { return __hip_atomic_load(p, __ATOMIC_RELAXED, __HIP_MEMORY_SCOPE_AGENT); }
__device__ __forceinline__ unsigned xb_add(unsigned* p, unsigned v) { return __hip_atomic_fetch_add(p, v, __ATOMIC_RELAXED, __HIP_MEMORY_SCOPE_AGENT); }
__device__ __forceinline__ unsigned xb_xcc_id() { return (unsigned)__builtin_amdgcn_s_getreg((3 << 11) | 20) & 0xFu; }
#define XB_SPIN(cond, bar) do { unsigned _sp = 0; while (cond) { __builtin_amdgcn_s_sleep(1); \
    if ((++_sp & 255u) == 0u) { if (xb_ld(&(bar)[XB_TMO])) break; if (_sp > XB_SPIN_CAP) { atomicAdd(&(bar)[XB_TMO], 1u); break; } } } } while (0)
struct XcdBarrier { unsigned* bar; unsigned x; volatile LAS unsigned* st; };
__device__ __forceinline__ XcdBarrier xcd_barrier_post(unsigned* bar, volatile LAS unsigned* st) {
    XcdBarrier b; b.bar = bar; b.x = xb_xcc_id(); b.st = st;
    if (threadIdx.x == 0) (void)xb_add(&bar[XB_XCNT(b.x)], 1u);
    return b;
}
__device__ __forceinline__ void xcd_barrier_complete(unsigned* bar, unsigned x, unsigned& nloc, unsigned& nx) {
    const unsigned G = gridDim.x * gridDim.y * gridDim.z;
    unsigned sum, cnt, mine, sp = 0u;
    for (;;) {
        sum = 0u; cnt = 0u; mine = 0u;
#pragma unroll
        for (unsigned j = 0; j < 16; ++j) { const unsigned c = xb_ld(&bar[XB_XCNT(j)]); sum += c; cnt += (c > 0u) ? 1u : 0u; mine = (j == x) ? c : mine; }
        if (sum == G) break;
        __builtin_amdgcn_s_sleep(1);
        if ((++sp & 255u) == 0u) { if (xb_ld(&bar[XB_TMO])) break; if (sp > XB_SPIN_CAP) { atomicAdd(&bar[XB_TMO], 1u); break; } }
    }
    nloc = mine > 0u ? mine : 1u; nx = cnt > 0u ? cnt : 1u;
}
__device__ __forceinline__ void xcd_barrier(const XcdBarrier& b) {
    asm volatile("s_waitcnt vmcnt(0)" ::: "memory");
    __syncthreads();
    if (threadIdx.x == 0) {
        unsigned* bar = b.bar;
        __builtin_amdgcn_s_waitcnt(0);
        unsigned nloc = b.st[0], nx = b.st[1];
        if (nloc == 0u) { xcd_barrier_complete(bar, b.x, nloc, nx); b.st[0] = nloc; b.st[1] = nx; }
        const unsigned old = xb_add(&bar[XB_XSUB(b.x)], 1u);
        const unsigned gen = old / nloc;
        if (old + 1u == (gen + 1u) * nloc) {
            __builtin_amdgcn_fence(__ATOMIC_RELEASE, "agent");
            asm volatile("s_waitcnt vmcnt(0)" ::: "memory");
            const unsigned og = xb_add(&bar[XB_TOP], 1u);
            const unsigned tg = og / nx;
            if (og + 1u == (tg + 1u) * nx) xb_add(&bar[XB_TOPGEN], 1u);
            else XB_SPIN(xb_ld(&bar[XB_TOPGEN]) == tg, bar);
            __builtin_amdgcn_fence(__ATOMIC_ACQUIRE, "agent");
            xb_add(&bar[XB_XGEN(b.x)], 1u);
            asm volatile("s_waitcnt vmcnt(0)" ::: "memory");
        } else {
            XB_SPIN(xb_ld(&bar[XB_XGEN(b.x)]) == gen, bar);
            __builtin_amdgcn_fence(__ATOMIC_ACQUIRE, "agent");
            asm volatile("s_waitcnt vmcnt(0)" ::: "memory");
        }
    }
    __syncthreads();
}

struct Args { const float* in[23]; float* out; unsigned char* ws; int ph_lo, ph_hi, li, pad; };
struct Frame {
    LAS unsigned char* lds; int tid, lane, wave, bid, G, gw, NGW;
};
#define LDS_WAIT() asm volatile("s_waitcnt lgkmcnt(0)" ::: "memory")

__device__ __forceinline__ const float* kp_in(int k) { int kv = k; asm volatile("" : "+v"(kv)); const char __attribute__((address_space(4)))* kp = (const char __attribute__((address_space(4)))*)__builtin_amdgcn_kernarg_segment_ptr();
    return *(const float* const __attribute__((address_space(4)))*)(kp + 8 * kv); }
constexpr int P0_MODU = 96;
__device__ __forceinline__ void p0_mod_unit(const Frame& F, const Args& a, int unit) {
    const float* c = kp_in(1); const float* w_mod = kp_in(2); const float* b_mod = kp_in(3); float* mod = (float*)(a.ws + WS_MOD);
    LAS float* cs = (LAS float*)F.lds;
    LAS float* red = (LAS float*)(F.lds + 32768);
    for (int i = F.tid; i < 4 * 2048; i += NTHREADS) { const float v = c[i]; cs[i] = v / (1.f + __expf(-v)); }
    __syncthreads();
    const int l = unit / 48, cb = (unit % 48) * 256; const int n4 = F.lane * 4;
    const float* w = w_mod + (size_t)l * D * MODW + cb + n4;
    f32x4 acc[4] = {{0, 0, 0, 0}, {0, 0, 0, 0}, {0, 0, 0, 0}, {0, 0, 0, 0}};
#pragma unroll 16
    for (int i = 0; i < 256; ++i) { const int k = F.wave * 256 + i; const f32x4 wv = __builtin_nontemporal_load((const f32x4*)(w + (size_t)k * MODW));
#pragma unroll
        for (int b = 0; b < 4; ++b) acc[b] += wv * cs[b * 2048 + k]; }
#pragma unroll
    for (int b = 0; b < 4; ++b) *(LAS f32x4*)(red + (F.wave * 4 + b) * 256 + n4) = acc[b];
    __syncthreads();
    for (int o = F.tid; o < 1024; o += NTHREADS) { const int b = o >> 8, n = o & 255; float s2 = 0.f;
#pragma unroll
        for (int w8 = 0; w8 < 8; ++w8) s2 += red[(w8 * 4 + b) * 256 + n];
        mod[(size_t)(l * 4 + b) * MODW + cb + n] = s2 + b_mod[l * MODW + cb + n]; }
    __syncthreads();
}
struct P0Item { const float* src; unsigned char* dst; int N, dpitch, fp8; float sc; };
constexpr int IT_IN = 3072, IT_OUT = 1024, IT_E = 65 * 256;
#ifndef NWORK
#define NWORK 0
#endif
constexpr int PSEG0 = IT_IN, PSEG1 = PSEG0 + IT_OUT, PSEG2 = PSEG1 + 2 * IT_E, PSEG3 = PSEG2 + IT_E, PITEMS = PSEG3;
constexpr int WSEG0 = IT_IN, WSEG1 = WSEG0 + IT_OUT, WSEG2 = WSEG1 + 2 * IT_E, WSEG3 = WSEG2 + IT_E, WITEMS = WSEG3;
enum { TT_IN = 0, TT_OUT = 1, TT_W1 = 2, TT_W2 = 3 };
__device__ __forceinline__ P0Item p0_tile_desc(const Args& a, int l, int type, int r) {
    unsigned char* ws = a.ws; P0Item d;
    if (type == TT_IN) { const bool f8 = (DENSE1_FP8 && l == 1) || (DENSE0_QKV8 && l == 0); const float* m = kp_in(6) + (size_t)l * D * 3 * D; d.N = 3 * D;
        if (f8) { const int kt = r / 192, nt = r % 192; d.src = m + (size_t)kt * 128 * 3 * D + nt * 32; d.dst = ws + WS_WIN + (size_t)l * 24 * MiB + ((size_t)nt * 32) * D + kt * 128; d.dpitch = D; d.fp8 = 1; d.sc = WD_SC; }
        else { const int kt = r / 96, nt = r % 96; d.src = m + (size_t)kt * 64 * 3 * D + nt * 64; d.dst = ws + WS_WIN + (((size_t)l * 3 * D + nt * 64) * D + kt * 64) * 2; d.dpitch = D * 2; d.fp8 = 0; d.sc = 1.f; }
        return d; }
    if (type == TT_OUT) { const bool f8 = (DENSE1_FP8 && l == 1) || (DENSE0_OUT8 && l == 0); const float* m = kp_in(7) + (size_t)l * D * D; d.N = D;
        if (f8) { const int kt = r / 64, nt = r % 64; d.src = m + (size_t)kt * 128 * D + nt * 32; d.dst = ws + WS_WOUT + (size_t)l * 8 * MiB + ((size_t)nt * 32) * D + kt * 128; d.dpitch = D; d.fp8 = 1; d.sc = WD_SC; }
        else { const int kt = r / 32, nt = r % 32; d.src = m + (size_t)kt * 64 * D + nt * 64; d.dst = ws + WS_WOUT + (((size_t)l * D + nt * 64) * D + kt * 64) * 2; d.dpitch = D * 2; d.fp8 = 0; d.sc = 1.f; }
        return d; }
    if (type == TT_W1) { const int up = r / IT_E; r %= IT_E; const int e = r / 256, kt = (r % 256) / 16, nt = r % 16;
        const float* m = (e < NE) ? kp_in(up ? 18 : 17) + ((size_t)l * NE + e) * D * EF : kp_in(up ? 21 : 20) + (size_t)l * D * EF;
        const int n0 = nt * 32, drow = (n0 / 128) * 256 + up * 128 + (n0 % 128);
        d.src = m + (size_t)kt * 128 * EF + n0; d.N = EF; d.dst = ws + WS_W1 + (((size_t)l * 65 + e) * 1024 + drow) * D + kt * 128; d.dpitch = D; d.fp8 = 1; d.sc = W1_SC; return d; }
    { const int e = r / 256, kt = (r % 256) / 64, nt = r % 64;
        const float* m = (e < NE) ? kp_in(19) + ((size_t)l * NE + e) * EF * D : kp_in(22) + (size_t)l * EF * D;
        d.src = m + (size_t)kt * 128 * D + nt * 32; d.N = D; d.dst = ws + WS_W2 + (((size_t)l * 65 + e) * D + nt * 32) * EF + kt * 128; d.dpitch = EF; d.fp8 = 1; d.sc = W2_SC; return d; }
}
__device__ __forceinline__ P0Item p0_decode_l(const Args& a, int l, int i) {
    if (i < WSEG0) return p0_tile_desc(a, l, TT_IN, i);
    if (i < WSEG1) return p0_tile_desc(a, l, TT_OUT, i - WSEG0);
    if (i < WSEG2) return p0_tile_desc(a, l, TT_W1, i - WSEG1);
    return p0_tile_desc(a, l, TT_W2, i - WSEG2);
}
__device__ __forceinline__ P0Item p0_decode_w(const Args& a, int i) { return p0_decode_l(a, 1, i); }
#define P0_LOAD(d, v) do { const int g_ = (d).fp8 ? (lane >> 3) : (lane >> 4), c_ = (d).fp8 ? (lane & 7) * 4 : (lane & 15) * 4; \
    _Pragma("unroll") for (int i_ = 0; i_ < 16; ++i_) v[i_] = __builtin_nontemporal_load((const f32x4*)((d).src + (size_t)(16 * g_ + i_) * (d).N + c_)); } while (0)
__device__ __forceinline__ void p0_store(const P0Item& d, const f32x4 (&v)[16], int lane) {
    if (d.fp8) { const int g = lane >> 3, nb = (lane & 7) * 4;
#pragma unroll
        for (int j = 0; j < 4; ++j) { u32x4 o;
            o.x = pk4_fp8(v[0][j] * d.sc, v[1][j] * d.sc, v[2][j] * d.sc, v[3][j] * d.sc); o.y = pk4_fp8(v[4][j] * d.sc, v[5][j] * d.sc, v[6][j] * d.sc, v[7][j] * d.sc);
            o.z = pk4_fp8(v[8][j] * d.sc, v[9][j] * d.sc, v[10][j] * d.sc, v[11][j] * d.sc); o.w = pk4_fp8(v[12][j] * d.sc, v[13][j] * d.sc, v[14][j] * d.sc, v[15][j] * d.sc);
            *(u32x4*)(d.dst + (size_t)(nb + j) * d.dpitch + 16 * g) = o; }
    } else { const int g = lane >> 4, nb = (lane & 15) * 4;
#pragma unroll
        for (int j = 0; j < 4; ++j) { u32x4 o0, o1;
            o0.x = cvt_pk_bf16(v[0][j], v[1][j]); o0.y = cvt_pk_bf16(v[2][j], v[3][j]); o0.z = cvt_pk_bf16(v[4][j], v[5][j]); o0.w = cvt_pk_bf16(v[6][j], v[7][j]);
            o1.x = cvt_pk_bf16(v[8][j], v[9][j]); o1.y = cvt_pk_bf16(v[10][j], v[11][j]); o1.z = cvt_pk_bf16(v[12][j], v[13][j]); o1.w = cvt_pk_bf16(v[14][j], v[15][j]);
            unsigned char* p = d.dst + (size_t)(nb + j) * d.dpitch + 32 * g; *(u32x4*)p = o0; *(u32x4*)(p + 16) = o1; }
    }
}
struct P0W { const float* src; unsigned char* dst; int N, dpitch, nt, up, w1; float sc; };
constexpr int P0W_IN = 8 * 24, P0W_OUT = 8 * 8, P0W_E1 = 16 * 65, P0W_E2 = 16 * 65, P0W_L = P0W_IN + P0W_OUT + 2 * P0W_E1 + P0W_E2, P0W_TOT = 2 * P0W_L;
__device__ __forceinline__ P0W p0w_decode(const Args& a, int it) {
    asm volatile("" : "+v"(it));
    unsigned char* ws = a.ws; P0W d; d.up = 0; d.w1 = 0;
    const int l = it / P0W_L; int r = it % P0W_L;
    if (r < P0W_IN) { const int kt = r / 24, nt = r % 24; d.src = kp_in(6) + (size_t)l * D * 3 * D + (size_t)kt * 256 * 3 * D + nt * 256; d.N = 3 * D; d.nt = nt;
        d.dst = ws + WS_WIN + (size_t)l * 24 * MiB + kt * 256; d.dpitch = D; d.sc = WD_SC; return d; }
    r -= P0W_IN;
    if (r < P0W_OUT) { const int kt = r / 8, nt = r % 8; d.src = kp_in(7) + (size_t)l * D * D + (size_t)kt * 256 * D + nt * 256; d.N = D; d.nt = nt;
        d.dst = ws + WS_WOUT + (size_t)l * 8 * MiB + kt * 256; d.dpitch = D; d.sc = WD_SC; return d; }
    r -= P0W_OUT;
    if (r < 2 * P0W_E1) { const int up = r / P0W_E1; r %= P0W_E1; const int e = r / 16, kt = (r % 16) / 2, nt = r % 2;
        const float* m = (e < NE) ? kp_in(up ? 18 : 17) + ((size_t)l * NE + e) * D * EF : kp_in(up ? 21 : 20) + (size_t)l * D * EF;
        d.src = m + (size_t)kt * 256 * EF + nt * 256; d.N = EF; d.nt = nt; d.up = up; d.w1 = 1;
        d.dst = ws + WS_W1 + (((size_t)l * 65 + e) * 1024) * D + kt * 256; d.dpitch = D; d.sc = W1_SC; return d; }
    r -= 2 * P0W_E1;
    { const int e = r / 16, kt = (r % 16) / 8, nt = r % 8;
        const float* m = (e < NE) ? kp_in(19) + ((size_t)l * NE + e) * EF * D : kp_in(22) + (size_t)l * EF * D;
        d.src = m + (size_t)kt * 256 * D + nt * 256; d.N = D; d.nt = nt;
        d.dst = ws + WS_W2 + (((size_t)l * 65 + e) * D) * EF + kt * 256; d.dpitch = EF; d.sc = W2_SC; return d; }
}
#define P0W_LOAD(d, v, h) do { _Pragma("unroll") for (int i_ = 0; i_ < 16; ++i_) v[i_] = __builtin_nontemporal_load((const f32x4*)((d).src + (size_t)((h) * 128 + 16 * w + i_) * (d).N + 4 * lane)); } while (0)
constexpr int P0W_PITCH = 256;
__device__ __forceinline__ void p0w_pack(const Frame& F, float sc, const f32x4 (&v)[16], int par, int h, int lane, int w) {
    LAS unsigned char* img = F.lds + par * (256 * P0W_PITCH);
#pragma unroll
    for (int j = 0; j < 4; ++j) { u32x4 o;
        o.x = pk4_fp8(v[0][j] * sc, v[1][j] * sc, v[2][j] * sc, v[3][j] * sc); o.y = pk4_fp8(v[4][j] * sc, v[5][j] * sc, v[6][j] * sc, v[7][j] * sc);
        o.z = pk4_fp8(v[8][j] * sc, v[9][j] * sc, v[10][j] * sc, v[11][j] * sc); o.w = pk4_fp8(v[12][j] * sc, v[13][j] * sc, v[14][j] * sc, v[15][j] * sc);
        const int r = j * 64 + lane; *(LAS u32x4*)(img + r * P0W_PITCH + (((h * 8 + w) ^ (r & 15)) * 16)) = o; }
}
__device__ __forceinline__ void p0w_store(const Frame& F, const P0W& d, int par, int lane, int w) {
    LAS unsigned char* img = F.lds + par * (256 * P0W_PITCH);
#pragma unroll
    for (int s2 = 0; s2 < 8; ++s2) { const int r = 32 * w + 4 * s2 + (lane >> 4), c = lane & 15; const u32x4 val = *(const LAS u32x4*)(img + r * P0W_PITCH + ((c ^ (r & 15)) * 16));
        const int ng = d.nt * 256 + 4 * (r & 63) + (r >> 6); const int row = d.w1 ? ((ng >> 7) * 256 + d.up * 128 + (ng & 127)) : ng;
        __builtin_nontemporal_store(val, (u32x4*)(d.dst + (size_t)row * d.dpitch + 16 * c)); }
}
__device__ __forceinline__ void p0_convert_stream(const Frame& F, const Args& a) {
    const int lane = (int)(threadIdx.x & 63u); const int w = __builtin_amdgcn_readfirstlane((int)(threadIdx.x >> 6)); f32x4 va[16], vb[16]; int par = 0; const int G = (int)gridDim.x, bid = (int)blockIdx.x;
    static_assert(2 * 256 * P0W_PITCH <= RING_BYTES, "prologue images must stay below the table / control words");
    constexpr int P0W_XTRA = 8; const int E = G > P0_MODU ? G - P0_MODU : 0, X = P0W_XTRA * E; const bool ex = bid >= P0_MODU;
#define P0W_IT(v) ((ex && (v) < P0W_XTRA) ? (bid - P0_MODU) + E * (v) : X + bid + G * ((v) - (ex ? P0W_XTRA : 0)))
    __syncthreads();
    int v = 0, it = P0W_IT(0);
    if (it < P0W_TOT) { const P0W d = p0w_decode(a, it); P0W_LOAD(d, va, 0); }
    while (it < P0W_TOT) {
        { const P0W d = p0w_decode(a, it); P0W_LOAD(d, vb, 1); p0w_pack(F, d.sc, va, par, 0, lane, w); }
        const int itn = P0W_IT(v + 1);
        if (itn < P0W_TOT) { const P0W d = p0w_decode(a, itn); P0W_LOAD(d, va, 0); }
        { const P0W d = p0w_decode(a, it); p0w_pack(F, d.sc, vb, par, 1, lane, w); __syncthreads(); p0w_store(F, d, par, lane, w); }
        par ^= 1; it = itn; ++v;
    }
#undef P0W_IT
    __syncthreads();
}
#ifndef P0_STREAM
#define P0_STREAM 1
#endif
#ifndef FUSE_N1
#define FUSE_N1 1
#endif
constexpr int CW_MODCNT = 80;
__device__ __forceinline__ void phase_norm_x(const Frame& F, const float* x, const float* g, const float* modl, int ish, int isc, unsigned char* XN8);
__device__ __forceinline__ void p0_prologue(const Frame& F, const Args& a) {
    for (int mu = F.bid; mu < P0_MODU; mu += F.G) { p0_mod_unit(F, a, mu);
#if FUSE_N1
        asm volatile("s_waitcnt vmcnt(0)" ::: "memory"); __syncthreads();
        if (F.tid == 0) { __builtin_amdgcn_fence(__ATOMIC_RELEASE, "agent"); asm volatile("s_waitcnt vmcnt(0)" ::: "memory"); (void)xb_add((unsigned*)(a.ws + WS_CTL) + CW_MODCNT, 1u); }
#endif
    }
    const int lane = F.lane;
#if P0_STREAM && DENSE1_FP8 && DENSE0_QKV8 && DENSE0_OUT8 && NWORK == 0
    p0_convert_stream(F, a);
    constexpr int PTOT = 0;
    f32x4 va[16], vb[16]; P0Item da, db;
    int it = F.gw;
#else
    f32x4 va[16], vb[16]; P0Item da, db;
    int it = F.gw;
    constexpr int PTOT = (NWORK > 0 ? 1 : 2) * PITEMS;
#endif
    if (it < PTOT) { da = p0_decode_l(a, it / PITEMS, it % PITEMS); P0_LOAD(da, va); }
    while (it < PTOT) {
        int itn = it + F.NGW;
        if (itn < PTOT) { db = p0_decode_l(a, itn / PITEMS, itn % PITEMS); P0_LOAD(db, vb); }
        p0_store(da, va, lane);
        it = itn; if (it >= PTOT) break;
        itn = it + F.NGW;
        if (itn < PTOT) { da = p0_decode_l(a, itn / PITEMS, itn % PITEMS); P0_LOAD(da, va); }
        p0_store(db, vb, lane);
        it = itn;
    }
#ifdef PROBE_P0R
    { f32x4 acc_ = {0.f, 0.f, 0.f, 0.f};
      for (int i2 = F.gw; i2 < PTOT; i2 += F.NGW) { const P0Item d2 = p0_decode_l(a, i2 / PITEMS, i2 % PITEMS); f32x4 v2[16]; P0_LOAD(d2, v2);
#pragma unroll
          for (int q = 0; q < 16; ++q) acc_ += v2[q]; }
      if (acc_[0] + acc_[1] + acc_[2] + acc_[3] == 123456.789f) ((float*)(a.ws + WS_LOGIT))[F.tid] = acc_[0]; }
#endif
    for (int r = F.gw; r < 512; r += F.NGW) {
        const int l = r >> 8, rr = r & 255; bf16_t* dst = (bf16_t*)(a.ws + WS_WR) + ((size_t)l * 256 + rr) * D; const float* src = kp_in(15) + ((size_t)l * NE + rr) * D;
#pragma unroll
        for (int j = 0; j < 4; ++j) { const int k = (j * 64 + lane) * 8; u32x4 o = {0u, 0u, 0u, 0u};
            if (rr < NE) { const f32x4 x0 = *(const f32x4*)(src + k), x1 = *(const f32x4*)(src + k + 4); o.x = cvt_pk_bf16(x0[0], x0[1]); o.y = cvt_pk_bf16(x0[2], x0[3]); o.z = cvt_pk_bf16(x1[0], x1[1]); o.w = cvt_pk_bf16(x1[2], x1[3]); }
            *(u32x4*)(dst + k) = o; } }
    int* tok = (int*)(a.ws + WS_TOK);
    for (int t = F.bid * NTHREADS + F.tid; t < T; t += F.G * NTHREADS) tok[NSR + t] = t;
#if FUSE_N1
    if (F.tid == 0) { unsigned* mc = (unsigned*)(a.ws + WS_CTL) + CW_MODCNT; unsigned sp = 0; while (xb_ld(mc) < (unsigned)P0_MODU) { __builtin_amdgcn_s_sleep(1); if (++sp > (1u << 26)) break; }
        __builtin_amdgcn_fence(__ATOMIC_ACQUIRE, "agent"); asm volatile("s_waitcnt vmcnt(0)" ::: "memory"); }
    __syncthreads();
    phase_norm_x(F, a.in[0], a.in[4], (const float*)(a.ws + WS_MOD), 0, 1, a.ws + WS_XN8);
#endif
}
__device__ __forceinline__ void worker_phase(const Frame& F, const Args& a, int p, int need, int& nxt, int wstride, int ncompute) {
    volatile LAS int* go = (volatile LAS int*)(F.lds + TAB_MISC + 512);
    unsigned* done = (unsigned*)(a.ws + WS_CTL) + 1024 + 64 * p;
    const int lane = F.lane; int polls = 0;
    for (;;) {
        const bool must = nxt < need;
        if (!must && go[0] == p + 1) break;
        if (nxt < WITEMS) {
            f32x4 va[16], vb[16]; const int n2 = nxt + wstride; const bool two = n2 < WITEMS;
            const P0Item da = p0_decode_w(a, nxt); P0_LOAD(da, va);
            if (two) { const P0Item db = p0_decode_w(a, n2); P0_LOAD(db, vb); p0_store(da, va, lane); p0_store(db, vb, lane); nxt = n2 + wstride; }
            else { p0_store(da, va, lane); nxt = n2; }
        } else __builtin_amdgcn_s_sleep(32);
        if (F.wave == 0 && ((++polls & 3) == 0 || nxt >= WITEMS)) { const unsigned v = __hip_atomic_load(done, __ATOMIC_RELAXED, __HIP_MEMORY_SCOPE_AGENT); if (v >= (unsigned)ncompute) go[0] = p + 1; }
    }
}

template <bool INBF> __device__ __forceinline__ void phase_norm(const Frame& F, const void* x, const float* g, const float* modl, int ish, int isc, bf16_t* XN, unsigned char* XN8) {
    float gs[4][8], shv[4][8]; int bcur = -1;
    const int rpw = (T + F.NGW - 1) / F.NGW, t0 = F.gw * rpw, t1 = (t0 + rpw < T) ? t0 + rpw : T;
    for (int t = t0; t < t1; ++t) { const int b = t / S;
        if (b != bcur) { bcur = b; const float* sh = modl + (size_t)b * MODW + ish * D; const float* sc = modl + (size_t)b * MODW + isc * D;
#pragma unroll
            for (int j = 0; j < 4; ++j) { const int d = (j * 64 + F.lane) * 8;
#pragma unroll
                for (int hh = 0; hh < 2; ++hh) { const f32x4 gv = *(const f32x4*)(g + d + 4 * hh), s1 = *(const f32x4*)(sc + d + 4 * hh), s0 = *(const f32x4*)(sh + d + 4 * hh);
#pragma unroll
                    for (int i = 0; i < 4; ++i) { gs[j][4 * hh + i] = gv[i] * (1.f + s1[i]); shv[j][4 * hh + i] = s0[i]; } } } }
        float v[4][8]; float ss = 0.f;
#pragma unroll
        for (int j = 0; j < 4; ++j) { const int d = (j * 64 + F.lane) * 8;
            if (INBF) { const u32x4 w = *(const u32x4*)((const bf16_t*)x + (size_t)t * D + d); v[j][0] = bf_lo(w.x); v[j][1] = bf_hi(w.x); v[j][2] = bf_lo(w.y); v[j][3] = bf_hi(w.y); v[j][4] = bf_lo(w.z); v[j][5] = bf_hi(w.z); v[j][6] = bf_lo(w.w); v[j][7] = bf_hi(w.w); }
            else { const f32x4 a0 = *(const f32x4*)((const float*)x + (size_t)t * D + d), a1 = *(const f32x4*)((const float*)x + (size_t)t * D + d + 4); v[j][0] = a0[0]; v[j][1] = a0[1]; v[j][2] = a0[2]; v[j][3] = a0[3]; v[j][4] = a1[0]; v[j][5] = a1[1]; v[j][6] = a1[2]; v[j][7] = a1[3]; }
#pragma unroll
            for (int i = 0; i < 8; ++i) ss += v[j][i] * v[j][i]; }
        const float r = rsqrtf(wave_sum(ss) * (1.f / D) + EPS);
#pragma unroll
        for (int j = 0; j < 4; ++j) { const int d = (j * 64 + F.lane) * 8; float y[8];
#pragma unroll
            for (int i = 0; i < 8; ++i) y[i] = v[j][i] * r * gs[j][i] + shv[j][i];
            if (XN) { u32x4 o; o.x = cvt_pk_bf16(y[0], y[1]); o.y = cvt_pk_bf16(y[2], y[3]); o.z = cvt_pk_bf16(y[4], y[5]); o.w = cvt_pk_bf16(y[6], y[7]); *(u32x4*)(XN + (size_t)t * D + d) = o; }
            if (XN8) { u32x2 o8; o8.x = pk4_fp8(y[0], y[1], y[2], y[3]); o8.y = pk4_fp8(y[4], y[5], y[6], y[7]); *(u32x2*)(XN8 + (size_t)t * D + d) = o8; } }
    }
}
__device__ __forceinline__ void phase_norm_x(const Frame& F, const float* x, const float* g, const float* modl, int ish, int isc, unsigned char* XN8) {
    f32x4 gs[8], shv[8]; int bcur = -1;
    const int rpw = (T + F.NGW - 1) / F.NGW, t0 = F.gw * rpw, t1 = (t0 + rpw < T) ? t0 + rpw : T;
    for (int t = t0; t < t1; ++t) { const int b = t / S;
        if (b != bcur) { bcur = b; const float* sh = modl + (size_t)b * MODW + ish * D; const float* sc = modl + (size_t)b * MODW + isc * D;
#pragma unroll
            for (int i = 0; i < 8; ++i) { const int d = 256 * i + 4 * F.lane; const f32x4 gv = *(const f32x4*)(g + d), s1 = *(const f32x4*)(sc + d); gs[i] = gv * (1.f + s1); shv[i] = *(const f32x4*)(sh + d); } }
        f32x4 v[8]; float ss = 0.f;
#pragma unroll
        for (int i = 0; i < 8; ++i) v[i] = *(const f32x4*)(x + (size_t)t * D + 256 * i + 4 * F.lane);
#pragma unroll
        for (int i = 0; i < 8; ++i) ss += v[i][0] * v[i][0] + v[i][1] * v[i][1] + v[i][2] * v[i][2] + v[i][3] * v[i][3];
        const float r = rsqrtf(wave_sum(ss) * (1.f / D) + EPS);
#pragma unroll
        for (int i = 0; i < 8; ++i) { const f32x4 y = v[i] * r * gs[i] + shv[i];
            *(unsigned*)(XN8 + (size_t)t * D + 256 * i + 4 * F.lane) = pk4_fp8(y[0], y[1], y[2], y[3]); }
    }
}
__device__ __forceinline__ void phase_qknorm(const Frame& F, bf16_t* QKV, const float* qn, const float* kn) {
    for (int t = F.gw; t < T; t += F.NGW) { bf16_t* row = QKV + (size_t)t * (3 * D);
#pragma unroll
        for (int j = 0; j < 8; ++j) { const int e0 = (j * 64 + F.lane) * 8; const u32x4 w = *(const u32x4*)(row + e0);
            float x[8] = {bf_lo(w.x), bf_hi(w.x), bf_lo(w.y), bf_hi(w.y), bf_lo(w.z), bf_hi(w.z), bf_lo(w.w), bf_hi(w.w)}; float ss = 0.f;
#pragma unroll
            for (int i = 0; i < 8; ++i) ss += x[i] * x[i];
            ss += __shfl_xor(ss, 1); ss += __shfl_xor(ss, 2); ss += __shfl_xor(ss, 4); ss += __shfl_xor(ss, 8);
            const float r = rsqrtf(ss * (1.f / 128.f) + EPS); const float* wv = (e0 < D ? qn : kn) + (e0 & 127);
            u32x4 o; o.x = cvt_pk_bf16(x[0] * r * wv[0], x[1] * r * wv[1]); o.y = cvt_pk_bf16(x[2] * r * wv[2], x[3] * r * wv[3]); o.z = cvt_pk_bf16(x[4] * r * wv[4], x[5] * r * wv[5]); o.w = cvt_pk_bf16(x[6] * r * wv[6], x[7] * r * wv[7]);
            *(u32x4*)(row + e0) = o; } }
}
__device__ __forceinline__ void phase_dacombine(const Frame& F, const bf16_t* OT, const Args& a, float lambda_init, bf16_t* O) {
    const float* lq1 = a.in[10]; const float* lk1 = a.in[11]; const float* lq2 = a.in[12]; const float* lk2 = a.in[13]; const float* subln = a.in[14];
    float s1 = lq1[F.lane] * lk1[F.lane] + lq1[F.lane + 64] * lk1[F.lane + 64], s2 = lq2[F.lane] * lk2[F.lane] + lq2[F.lane + 64] * lk2[F.lane + 64];
    s1 = wave_sum(s1); s2 = wave_sum(s2);
    const float lam = __expf(s1) - __expf(s2) + lambda_init;
    for (int t = F.gw; t < T; t += F.NGW) {
#pragma unroll
        for (int j = 0; j < 4; ++j) { const int e0 = (j * 64 + F.lane) * 8; const u32x4 w1 = *(const u32x4*)(OT + (size_t)t * D + e0), w2 = *(const u32x4*)(OT + (size_t)(T + t) * D + e0);
            float x[8] = {bf_lo(w1.x) - lam * bf_lo(w2.x), bf_hi(w1.x) - lam * bf_hi(w2.x), bf_lo(w1.y) - lam * bf_lo(w2.y), bf_hi(w1.y) - lam * bf_hi(w2.y),
                          bf_lo(w1.z) - lam * bf_lo(w2.z), bf_hi(w1.z) - lam * bf_hi(w2.z), bf_lo(w1.w) - lam * bf_lo(w2.w), bf_hi(w1.w) - lam * bf_hi(w2.w)}; float ss = 0.f;
#pragma unroll
            for (int i = 0; i < 8; ++i) ss += x[i] * x[i];
            ss += __shfl_xor(ss, 1); ss += __shfl_xor(ss, 2); ss += __shfl_xor(ss, 4); ss += __shfl_xor(ss, 8); ss += __shfl_xor(ss, 16);
            const float r = rsqrtf(ss * (1.f / 256.f) + SUBLN_EPS) * (1.f - lambda_init); const float* wv = subln + (e0 & 255);
            u32x4 o; o.x = cvt_pk_bf16(x[0] * r * wv[0], x[1] * r * wv[1]); o.y = cvt_pk_bf16(x[2] * r * wv[2], x[3] * r * wv[3]); o.z = cvt_pk_bf16(x[4] * r * wv[4], x[5] * r * wv[5]); o.w = cvt_pk_bf16(x[6] * r * wv[6], x[7] * r * wv[7]);
            *(u32x4*)(O + (size_t)t * D + e0) = o; } }
}
__device__ __forceinline__ void phase_route(const Frame& F, const Args& a, int l) {
    const float* logits = (const float*)(a.ws + WS_LOGIT); const float* rbias = a.in[16] + l * NE;
    int* top_e = (int*)(a.ws + WS_TOPE); float* gate = (float*)(a.ws + WS_GATE); int* lpos = (int*)(a.ws + WS_LPOS); int* cnt = (int*)(a.ws + WS_CNT);
    LAS int* hist = (LAS int*)(F.lds + TAB_MISC);
    for (int tile = F.bid; tile < T / 64; tile += F.G) {
        __syncthreads();
        if (F.tid < NE) hist[F.tid] = 0;
        __syncthreads();
        const float bias = rbias[F.lane];
        float lgs[8];
#pragma unroll
        for (int i = 0; i < 8; ++i) { const int t = tile * 64 + F.wave * 8 + i;
            lgs[i] = (logits[(size_t)t * NE + F.lane] + logits[((size_t)T + t) * NE + F.lane]) + (logits[((size_t)2 * T + t) * NE + F.lane] + logits[((size_t)3 * T + t) * NE + F.lane]); }
#pragma unroll
        for (int i = 0; i < 8; ++i) { const int t = tile * 64 + F.wave * 8 + i, lane = F.lane;
            const float lg = lgs[i]; const float sc = 1.f / (1.f + __expf(-lg)); const float bb = sc + bias;
            float m1 = bb; m1 = fmaxf(m1, __shfl_xor(m1, 1)); m1 = fmaxf(m1, __shfl_xor(m1, 2)); m1 = fmaxf(m1, __shfl_xor(m1, 4));
            const unsigned long long eq = __ballot(bb == m1); const int gbase = lane & ~7; const unsigned grpmask = (unsigned)((eq >> gbase) & 0xffull);
            const int first = gbase + __builtin_ctz(grpmask);
            float m2 = (lane == first) ? -INFINITY : bb; m2 = fmaxf(m2, __shfl_xor(m2, 1)); m2 = fmaxf(m2, __shfl_xor(m2, 2)); m2 = fmaxf(m2, __shfl_xor(m2, 4));
            const float gs = m1 + m2; const int g = lane >> 3;
            int grank = 0;
#pragma unroll
            for (int g2 = 0; g2 < 8; ++g2) { const float v = __int_as_float(__builtin_amdgcn_readlane(__float_as_int(gs), g2 * 8)); grank += (v > gs || (v == gs && g2 < g)) ? 1 : 0; }
            const bool keep = grank < 4; const float val = keep ? bb : -INFINITY;
            int rank = 0;
#pragma unroll 8
            for (int e2 = 0; e2 < 64; ++e2) { const float v = __int_as_float(__builtin_amdgcn_readlane(__float_as_int(val), e2)); rank += (v > val || (v == val && e2 < lane)) ? 1 : 0; }
            const bool sel = rank < TOPK;
            const float ssum = wave_sum(sel ? sc : 0.f);
            if (sel) { const int p = atomicAdd((int*)(hist + lane), 1); top_e[t * TOPK + rank] = lane; gate[t * TOPK + rank] = sc / ssum * 2.5f; lpos[t * TOPK + rank] = p; }
        }
        __syncthreads();
        if (F.tid < NE) cnt[tile * NE + F.tid] = hist[F.tid];
    }
}
#ifndef FUSE_NRR
#define FUSE_NRR 1
#endif
__device__ __forceinline__ void phase_nrr(const Frame& F, const Args& a, int l, const bf16_t* XA, const float* g, const float* modl, unsigned char* XN8) {
    const bf16_t* Wr = (const bf16_t*)(a.ws + WS_WR) + (size_t)l * 256 * D; const float* rbias = a.in[16] + l * NE;
    int* top_e = (int*)(a.ws + WS_TOPE); float* gate = (float*)(a.ws + WS_GATE); int* lpos = (int*)(a.ws + WS_LPOS); int* cnt = (int*)(a.ws + WS_CNT);
    LAS int* hist = (LAS int*)(F.lds + TAB_MISC);
    constexpr int APITCH = 2064;
    static_assert(64 * APITCH <= RING_BYTES, "nrr tile");
    LAS unsigned char* At = F.lds; LAS float* Pl = (LAS float*)F.lds;
    const int lane = F.lane, w = F.wave, fr = lane & 15, fq = lane >> 4, eb = w & 3, kq = w >> 2;
    for (int tile = F.bid; tile < T / 64; tile += F.G) {
        const int tb = tile * 64 + w * 8, b = tb / S;
        __syncthreads();
        if (F.tid < NE) hist[F.tid] = 0;
        float rs[8];
#pragma unroll
        for (int i4 = 0; i4 < 2; ++i4) { u32x4 rw[4][4];
#pragma unroll
            for (int i = 0; i < 4; ++i)
#pragma unroll
                for (int j = 0; j < 4; ++j) rw[i][j] = *(const u32x4*)(XA + (size_t)(tb + 4 * i4 + i) * D + (j * 64 + lane) * 8);
#pragma unroll
            for (int i = 0; i < 4; ++i) { float ss = 0.f;
#pragma unroll
                for (int j = 0; j < 4; ++j)
#pragma unroll
                    for (int q = 0; q < 4; ++q) { const float x0 = bf_lo(rw[i][j][q]), x1 = bf_hi(rw[i][j][q]); ss += x0 * x0; ss += x1 * x1; }
                rs[4 * i4 + i] = rsqrtf(wave_sum(ss) * (1.f / D) + EPS); } }
        f32x4 acc[4] = {{0.f, 0.f, 0.f, 0.f}, {0.f, 0.f, 0.f, 0.f}, {0.f, 0.f, 0.f, 0.f}, {0.f, 0.f, 0.f, 0.f}};
        u32x4 raw[8][2];
#pragma unroll
        for (int i = 0; i < 8; ++i)
#pragma unroll
            for (int jj = 0; jj < 2; ++jj) raw[i][jj] = *(const u32x4*)(XA + (size_t)(tb + i) * D + (jj * 64 + lane) * 8);
#pragma unroll 1
        for (int h = 0; h < 2; ++h) {
            const bf16_t* wrow = Wr + (size_t)(16 * eb + fr) * D + h * 1024 + 512 * kq + 8 * fq;
            bf16x8 bv[16];
#pragma unroll
            for (int kb = 0; kb < 16; ++kb) bv[kb] = *(const bf16x8*)(wrow + 32 * kb);
            float gs[2][8], shv[2][8];
#pragma unroll
            for (int jj = 0; jj < 2; ++jj) { const int d = ((2 * h + jj) * 64 + lane) * 8; const float* sh = modl + (size_t)b * MODW + 3 * D; const float* sc = modl + (size_t)b * MODW + 4 * D;
#pragma unroll
                for (int hh = 0; hh < 2; ++hh) { const f32x4 gv = *(const f32x4*)(g + d + 4 * hh), s1 = *(const f32x4*)(sc + d + 4 * hh), s0 = *(const f32x4*)(sh + d + 4 * hh);
#pragma unroll
                    for (int q = 0; q < 4; ++q) { gs[jj][4 * hh + q] = gv[q] * (1.f + s1[q]); shv[jj][4 * hh + q] = s0[q]; } } }
            if (h == 1) __syncthreads();
#pragma unroll
            for (int i = 0; i < 8; ++i)
#pragma unroll
                for (int jj = 0; jj < 2; ++jj) { const u32x4 rw = raw[i][jj]; float y[8];
#pragma unroll
                    for (int q = 0; q < 4; ++q) { y[2 * q] = bf_lo(rw[q]) * rs[i] * gs[jj][2 * q] + shv[jj][2 * q]; y[2 * q + 1] = bf_hi(rw[q]) * rs[i] * gs[jj][2 * q + 1] + shv[jj][2 * q + 1]; }
                    u32x2 o8; o8.x = pk4_fp8(y[0], y[1], y[2], y[3]); o8.y = pk4_fp8(y[4], y[5], y[6], y[7]);
                    *(u32x2*)(XN8 + (size_t)(tb + i) * D + ((2 * h + jj) * 64 + lane) * 8) = o8;
                    u32x4 o; o.x = cvt_pk_bf16(y[0], y[1]); o.y = cvt_pk_bf16(y[2], y[3]); o.z = cvt_pk_bf16(y[4], y[5]); o.w = cvt_pk_bf16(y[6], y[7]);
                    *(LAS u32x4*)(At + (w * 8 + i) * APITCH + (jj * 64 + lane) * 16) = o; }
            if (h == 0) {
#pragma unroll
                for (int i = 0; i < 8; ++i)
#pragma unroll
                    for (int jj = 0; jj < 2; ++jj) raw[i][jj] = *(const u32x4*)(XA + (size_t)(tb + i) * D + ((2 + jj) * 64 + lane) * 8); }
            __syncthreads();
            const LAS unsigned char* arow = At + fr * APITCH + (512 * kq + 8 * fq) * 2;
#pragma unroll
            for (int kb = 0; kb < 16; ++kb) {
#pragma unroll
                for (int rb = 0; rb < 4; ++rb) { const bf16x8 av = *(const LAS bf16x8*)(arow + rb * 16 * APITCH + kb * 64);
                    acc[rb] = __builtin_amdgcn_mfma_f32_16x16x32_bf16(bv[kb], av, acc[rb], 0, 0, 0); } }
        }
        __syncthreads();
#pragma unroll
        for (int rb = 0; rb < 4; ++rb) *(LAS f32x4*)(Pl + (size_t)((kq * 64 + 16 * rb + fr) * NE + 16 * eb + 4 * fq)) = acc[rb];
        __syncthreads();
        const float bias = rbias[lane];
#pragma unroll
        for (int i = 0; i < 8; ++i) { const int t = tb + i;
            const float lg = Pl[(w * 8 + i) * NE + lane] + Pl[(64 + w * 8 + i) * NE + lane]; const float sc = 1.f / (1.f + __expf(-lg)); const float bb = sc + bias;
            float m1 = bb; m1 = fmaxf(m1, __shfl_xor(m1, 1)); m1 = fmaxf(m1, __shfl_xor(m1, 2)); m1 = fmaxf(m1, __shfl_xor(m1, 4));
            const unsigned long long eq = __ballot(bb == m1); const int gbase = lane & ~7; const unsigned grpmask = (unsigned)((eq >> gbase) & 0xffull);
            const int first = gbase + __builtin_ctz(grpmask);
            float m2 = (lane == first) ? -INFINITY : bb; m2 = fmaxf(m2, __shfl_xor(m2, 1)); m2 = fmaxf(m2, __shfl_xor(m2, 2)); m2 = fmaxf(m2, __shfl_xor(m2, 4));
            const float gsum = m1 + m2; const int gq = lane >> 3;
            int grank = 0;
#pragma unroll
            for (int g2 = 0; g2 < 8; ++g2) { const float v = __int_as_float(__builtin_amdgcn_readlane(__float_as_int(gsum), g2 * 8)); grank += (v > gsum || (v == gsum && g2 < gq)) ? 1 : 0; }
            const bool keep = grank < 4; const float val = keep ? bb : -INFINITY;
            int rank = 0;
#pragma unroll 8
            for (int e2 = 0; e2 < 64; ++e2) { const float v = __int_as_float(__builtin_amdgcn_readlane(__float_as_int(val), e2)); rank += (v > val || (v == val && e2 < lane)) ? 1 : 0; }
            const bool sel = rank < TOPK;
            const float ssum = wave_sum(sel ? sc : 0.f);
            if (sel) { const int p = atomicAdd((int*)(hist + lane), 1); top_e[t * TOPK + rank] = lane; gate[t * TOPK + rank] = sc / ssum * 2.5f; lpos[t * TOPK + rank] = p; }
        }
        __syncthreads();
        if (F.tid < NE) cnt[tile * NE + F.tid] = hist[F.tid];
    }
}
__device__ __forceinline__ void phase_sort(const Frame& F, const Args& a) {
    const int* cnt = (const int*)(a.ws + WS_CNT); const int* top_e = (const int*)(a.ws + WS_TOPE); const int* lpos = (const int*)(a.ws + WS_LPOS);
    int* slot_of = (int*)(a.ws + WS_SLOT); int* tok = (int*)(a.ws + WS_TOK); int* tile_e = (int*)(a.ws + WS_TILEE);
    LAS int* part = (LAS int*)F.lds;
    LAS int* off = (LAS int*)(F.lds + 4096);
    LAS int* base = (LAS int*)(F.lds + 8192);
    const int e = F.tid & 63, grp = F.tid >> 6;
    LAS int* pre = (LAS int*)(F.lds + 12288);
    __syncthreads();
    { int s = 0, p = 0;
#pragma unroll
      for (int i = 0; i < 32; ++i) { const int c = cnt[(grp * 32 + i) * NE + e]; s += c; p += (grp * 32 + i < F.bid) ? c : 0; }
      part[grp * 64 + e] = s; if (grp == F.bid / 32) pre[e] = p; }
    __syncthreads();
    if (F.tid < NE) {
        int tot = 0;
#pragma unroll
        for (int g2 = 0; g2 < 8; ++g2) tot += part[g2 * 64 + F.tid];
        const int pad = (tot + 255) / 256 * 256; int inc = pad;
#pragma unroll
        for (int o = 1; o < 64; o <<= 1) { const int v = __shfl_up(inc, o); if (F.tid >= o) inc += v; }
        off[F.tid] = inc - pad; if (F.tid == NE - 1) off[NE] = inc; }
    __syncthreads();
    if (F.bid == 0) {
        int nrt = off[NE] / 256; nrt = nrt < 0 ? 0 : (nrt > NSR / 256 ? NSR / 256 : nrt);
        if (F.tid < NE) { int r0 = off[F.tid] / 256, r1 = off[F.tid + 1] / 256; r0 = r0 < 0 ? 0 : r0; r1 = r1 > nrt ? nrt : r1; for (int rt = r0; rt < r1; ++rt) tile_e[rt] = F.tid; }
        for (int rt = nrt + F.tid; rt < NRT_MAX; rt += NTHREADS) tile_e[rt] = -1;
        if (F.tid == 0) tile_e[NRT_MAX] = nrt;
    }
    for (int tile = F.bid; tile < T / 64; tile += F.G) {
        __syncthreads();
        if (F.tid < NE) { int s = off[e]; const int g0 = tile / 32; for (int g2 = 0; g2 < g0; ++g2) s += part[g2 * 64 + e];
            if (tile == F.bid) s += pre[e]; else { for (int i = g0 * 32; i < tile; ++i) s += cnt[i * NE + e]; }
            base[e] = s; }
        __syncthreads();
        if (F.tid < 64 * TOPK) { const int i = tile * 64 * TOPK + F.tid; int sl = base[top_e[i]] + lpos[i]; if (sl < 0 || sl >= NSR) sl = NSR - 1;
            slot_of[i] = sl; tok[sl] = i / TOPK; }
    }
}
__device__ __forceinline__ void phase_combine_out(const Frame& F, const Args& a, const bf16_t* x1, const float* modl, float* outf) {
    const int* slot_of = (const int*)(a.ws + WS_SLOT); const float* gate = (const float*)(a.ws + WS_GATE);
    const unsigned char* Y = a.ws + WS_Y;
    int sl[TOPK + 1]; float gw[TOPK + 1];
    const int rpw = (T + F.NGW - 1) / F.NGW, t0 = F.gw * rpw, t1 = (t0 + rpw < T) ? t0 + rpw : T;
    int t = t0;
    if (t < t1) {
#pragma unroll
        for (int k = 0; k < TOPK; ++k) { sl[k] = slot_of[t * TOPK + k]; gw[k] = gate[t * TOPK + k]; } }
    f32x4 g2c[8]; int bcur = -1;
    for (; t < t1; ++t) { const int b = t / S;
        if (b != bcur) { bcur = b; const float* g2 = modl + (size_t)b * MODW + 5 * D;
#pragma unroll
            for (int i = 0; i < 8; ++i) g2c[i] = *(const f32x4*)(g2 + 256 * i + 4 * F.lane); }
        sl[TOPK] = NSR + t; gw[TOPK] = 1.f;
        unsigned yw[TOPK + 1][8]; u32x2 xr[8];
#pragma unroll
        for (int k = 0; k <= TOPK; ++k)
#pragma unroll
            for (int i = 0; i < 8; ++i) yw[k][i] = *(const unsigned*)(Y + (size_t)sl[k] * D + 256 * i + 4 * F.lane);
#pragma unroll
        for (int i = 0; i < 8; ++i) xr[i] = *(const u32x2*)(x1 + (size_t)t * D + 256 * i + 4 * F.lane);
        float gcur[TOPK + 1];
#pragma unroll
        for (int k = 0; k <= TOPK; ++k) gcur[k] = gw[k] * (1.f / Y_SC);
        const int tn = t + 1;
        if (tn < t1) {
#pragma unroll
            for (int k = 0; k < TOPK; ++k) { sl[k] = slot_of[tn * TOPK + k]; gw[k] = gate[tn * TOPK + k]; } }
#pragma unroll
        for (int i = 0; i < 8; ++i) { float y0 = 0.f, y1 = 0.f, y2 = 0.f, y3 = 0.f;
#pragma unroll
            for (int k = 0; k <= TOPK; ++k) { const f32x2 lo = __builtin_amdgcn_cvt_pk_f32_fp8((int)yw[k][i], false), hi2 = __builtin_amdgcn_cvt_pk_f32_fp8((int)yw[k][i], true); const float gk = gcur[k];
                y0 += gk * lo[0]; y1 += gk * lo[1]; y2 += gk * hi2[0]; y3 += gk * hi2[1]; }
            f32x4 o; o[0] = bf_lo(xr[i].x) + g2c[i][0] * y0; o[1] = bf_hi(xr[i].x) + g2c[i][1] * y1; o[2] = bf_lo(xr[i].y) + g2c[i][2] * y2; o[3] = bf_hi(xr[i].y) + g2c[i][3] * y3;
            *(f32x4*)(outf + (size_t)t * D + 256 * i + 4 * F.lane) = o; }
    }
}
__device__ __forceinline__ void phase_combine(const Frame& F, const Args& a, const bf16_t* x1, const float* modl, float* outf, bf16_t* outb, const float* gn, const float* modn, bf16_t* XN, unsigned char* XN8) {
    const int* slot_of = (const int*)(a.ws + WS_SLOT); const float* gate = (const float*)(a.ws + WS_GATE);
    const unsigned char* Y = a.ws + WS_Y;
    int sl[TOPK + 1]; float gw[TOPK + 1];
    const int rpw = (T + F.NGW - 1) / F.NGW, t0 = F.gw * rpw, t1 = (t0 + rpw < T) ? t0 + rpw : T;
    LAS float* gsl = (LAS float*)F.lds; LAS float* shl = gsl + D; const int bwg = (F.bid * NWAVES * rpw) / S;
    if (gn) { __syncthreads(); const float* sh_ = modn + (size_t)bwg * MODW; const float* sc_ = sh_ + D;
        for (int d = F.tid; d < D; d += NTHREADS) { gsl[d] = gn[d] * (1.f + sc_[d]); shl[d] = sh_[d]; }
        __syncthreads(); }
    int t = t0;
    if (t < t1) {
#pragma unroll
        for (int k = 0; k < TOPK; ++k) { sl[k] = slot_of[t * TOPK + k]; gw[k] = gate[t * TOPK + k]; } }
    float g2c[2][16]; int bcur = -1;
    for (; t < t1; ++t) { const int b = t / S;
        if (b != bcur) { bcur = b; const float* g2 = modl + (size_t)b * MODW + 5 * D;
#pragma unroll
            for (int j = 0; j < 2; ++j)
#pragma unroll
                for (int q = 0; q < 4; ++q) { const f32x4 ga = *(const f32x4*)(g2 + j * 1024 + F.lane * 16 + 4 * q); g2c[j][4 * q] = ga[0]; g2c[j][4 * q + 1] = ga[1]; g2c[j][4 * q + 2] = ga[2]; g2c[j][4 * q + 3] = ga[3]; } }
        sl[TOPK] = NSR + t; gw[TOPK] = 1.f;
        u32x4 yw[TOPK + 1][2]; u32x4 xr[4];
#pragma unroll
        for (int k = 0; k <= TOPK; ++k) { yw[k][0] = *(const u32x4*)(Y + (size_t)sl[k] * D + F.lane * 16); yw[k][1] = *(const u32x4*)(Y + (size_t)sl[k] * D + 1024 + F.lane * 16); }
#pragma unroll
        for (int q = 0; q < 4; ++q) xr[q] = *(const u32x4*)(x1 + (size_t)t * D + (q >> 1) * 1024 + F.lane * 16 + (q & 1) * 8);
        float gcur[TOPK + 1];
#pragma unroll
        for (int k = 0; k <= TOPK; ++k) gcur[k] = gw[k] * (1.f / Y_SC);
        const int tn = t + 1;
        if (tn < t1) {
#pragma unroll
            for (int k = 0; k < TOPK; ++k) { sl[k] = slot_of[tn * TOPK + k]; gw[k] = gate[tn * TOPK + k]; } }
        float xo[2][16]; float ss = 0.f;
#pragma unroll
        for (int j = 0; j < 2; ++j) { const int e0 = j * 1024 + F.lane * 16; float y[16];
#pragma unroll
            for (int i = 0; i < 16; ++i) y[i] = 0.f;
#pragma unroll
            for (int k = 0; k <= TOPK; ++k) { const u32x4 w = yw[k][j]; const float gk = gcur[k];
#pragma unroll
                for (int q = 0; q < 4; ++q) { const f32x2 lo = __builtin_amdgcn_cvt_pk_f32_fp8((int)w[q], false), hi2 = __builtin_amdgcn_cvt_pk_f32_fp8((int)w[q], true);
                    y[4 * q + 0] += gk * lo[0]; y[4 * q + 1] += gk * lo[1]; y[4 * q + 2] += gk * hi2[0]; y[4 * q + 3] += gk * hi2[1]; } }
            float xv[16];
#pragma unroll
            for (int hh = 0; hh < 2; ++hh) { const u32x4 w = xr[j * 2 + hh]; xv[8 * hh + 0] = bf_lo(w.x); xv[8 * hh + 1] = bf_hi(w.x); xv[8 * hh + 2] = bf_lo(w.y); xv[8 * hh + 3] = bf_hi(w.y); xv[8 * hh + 4] = bf_lo(w.z); xv[8 * hh + 5] = bf_hi(w.z); xv[8 * hh + 6] = bf_lo(w.w); xv[8 * hh + 7] = bf_hi(w.w); }
#pragma unroll
            for (int q = 0; q < 4; ++q) {
#pragma unroll
                for (int i = 0; i < 4; ++i) { const float r = xv[4 * q + i] + g2c[j][4 * q + i] * y[4 * q + i]; xo[j][4 * q + i] = r; ss += r * r; }
                if (outf) *(f32x4*)(outf + (size_t)t * D + e0 + 4 * q) = (f32x4){xo[j][4 * q], xo[j][4 * q + 1], xo[j][4 * q + 2], xo[j][4 * q + 3]}; }
            if (outb) { u32x4 w0, w1; w0.x = cvt_pk_bf16(xo[j][0], xo[j][1]); w0.y = cvt_pk_bf16(xo[j][2], xo[j][3]); w0.z = cvt_pk_bf16(xo[j][4], xo[j][5]); w0.w = cvt_pk_bf16(xo[j][6], xo[j][7]);
                w1.x = cvt_pk_bf16(xo[j][8], xo[j][9]); w1.y = cvt_pk_bf16(xo[j][10], xo[j][11]); w1.z = cvt_pk_bf16(xo[j][12], xo[j][13]); w1.w = cvt_pk_bf16(xo[j][14], xo[j][15]);
                *(u32x4*)(outb + (size_t)t * D + e0) = w0; *(u32x4*)(outb + (size_t)t * D + e0 + 8) = w1; } }
        if (gn) { const float r = rsqrtf(wave_sum(ss) * (1.f / D) + EPS); const float* sh = modn + (size_t)b * MODW; const float* sc = sh + D;
#pragma unroll
            for (int j = 0; j < 2; ++j) { const int e0 = j * 1024 + F.lane * 16; u32x4 w0, w1; float yv[16];
                if (b == bwg) {
#pragma unroll
                    for (int q = 0; q < 4; ++q) { const f32x4 gv = *(const LAS f32x4*)(gsl + e0 + 4 * q), s0 = *(const LAS f32x4*)(shl + e0 + 4 * q);
#pragma unroll
                        for (int i = 0; i < 4; ++i) yv[4 * q + i] = xo[j][4 * q + i] * r * gv[i] + s0[i]; }
                } else {
#pragma unroll
                    for (int q = 0; q < 4; ++q) { const f32x4 gv = *(const f32x4*)(gn + e0 + 4 * q), s1 = *(const f32x4*)(sc + e0 + 4 * q), s0 = *(const f32x4*)(sh + e0 + 4 * q);
#pragma unroll
                        for (int i = 0; i < 4; ++i) yv[4 * q + i] = xo[j][4 * q + i] * r * gv[i] * (1.f + s1[i]) + s0[i]; }
                }
                w0.x = cvt_pk_bf16(yv[0], yv[1]); w0.y = cvt_pk_bf16(yv[2], yv[3]); w0.z = cvt_pk_bf16(yv[4], yv[5]); w0.w = cvt_pk_bf16(yv[6], yv[7]);
                w1.x = cvt_pk_bf16(yv[8], yv[9]); w1.y = cvt_pk_bf16(yv[10], yv[11]); w1.z = cvt_pk_bf16(yv[12], yv[13]); w1.w = cvt_pk_bf16(yv[14], yv[15]);
                if (XN) { *(u32x4*)(XN + (size_t)t * D + e0) = w0; *(u32x4*)(XN + (size_t)t * D + e0 + 8) = w1; }
                if (XN8) { u32x4 w8; w8.x = pk4_fp8(yv[0], yv[1], yv[2], yv[3]); w8.y = pk4_fp8(yv[4], yv[5], yv[6], yv[7]); w8.z = pk4_fp8(yv[8], yv[9], yv[10], yv[11]); w8.w = pk4_fp8(yv[12], yv[13], yv[14], yv[15]); *(u32x4*)(XN8 + (size_t)t * D + e0) = w8; } } }
    }
}
constexpr int NPH = 13, N_PHASES = 1 + 2 * NPH;
enum { PH_NORM1 = 0, PH_QKV, PH_QKNORM, PH_ATTN, PH_DACOMB, PH_OUTPROJ, PH_NORM2, PH_ROUTER, PH_ROUTE, PH_SORT, PH_GEMM1, PH_GEMM2, PH_COMBINE };

__device__ __forceinline__ float uni_f(float x) { return __int_as_float(__builtin_amdgcn_readfirstlane(__float_as_int(x))); }
__device__ __forceinline__ void attn_phase_sb(const Frame& F, const Args& a) {
    att::AttnArgs A{(const bf16_t*)(a.ws + WS_QKV), (bf16_t*)(a.ws + WS_O), D};
    for (int u = F.bid; u < 1024; u += F.G) { const int bh = u >> 4, qq = u & 15; const int qb = ((bh >> 4) & 1) ? 15 - qq : qq; const int b = bh >> 4, h = bh & 15;
        att::attn_unit<0>(A, b, qb, h * 128, D + h * 128, 2 * D + h * 128, h * 128, 0.f, 0, (LAS char*)F.lds); }
}
__device__ __forceinline__ void attn_phase_da(const Frame& F, const Args& a) {
    const float* qn = a.in[8]; const float* kn = a.in[9];
    float gq = fmaxf(fabsf(qn[F.lane]), fabsf(qn[F.lane + 64])), gk = fmaxf(fabsf(kn[F.lane]), fabsf(kn[F.lane + 64]));
#pragma unroll
    for (int o = 1; o < 64; o <<= 1) { gq = fmaxf(gq, __shfl_xor(gq, o)); gk = fmaxf(gk, __shfl_xor(gk, o)); }
    const float zb2 = 128.f * gq * gk * 1.01f * att::QK_C;
    const float lambda_init = 0.8f - 0.6f * 0.7408182206817179f;
    unsigned* qctr = (unsigned*)(a.ws + WS_CTL) + 64;
    LAS unsigned* ubox = (LAS unsigned*)(F.lds + TAB_MISC);
    for (;;) {
        __syncthreads();
        if (F.tid == 0) ubox[0] = __hip_atomic_fetch_add(qctr, 1u, __ATOMIC_RELAXED, __HIP_MEMORY_SCOPE_AGENT);
        __syncthreads();
        const unsigned u = ubox[0];
        if (u >= 1024u) break;
        const int h = 7 - (int)(u >> 7), rem = (int)(u & 127u), qb = 31 - (rem >> 2), b = rem & 3;
        const float slope2 = exp2f(-(float)(h + 1)) * LOG2E;
        const float dm = (150.f + 2.f * zb2) / slope2; const int dmax = dm < 1.0e6f ? (int)dm + 1 : 1000000;
        const bool freeze_ok = (2.f * zb2 + 32.f * slope2) < 100.f;
        att::attn_unit_da((const bf16_t*)(a.ws + WS_QKV), (bf16_t*)(a.ws + WS_O), b, h, qb, slope2, dmax, freeze_ok, a.in, lambda_init, (LAS char*)F.lds); }
}
__device__ __forceinline__ int need_before(int p) {
    return p <= NPH ? 0 : WITEMS;
}
#define IN(k) (lo <= (k) && (k) < hi)
#ifdef PROBE_BAR2
#define SEAM(k) do { if (IN((k) + 1)) { xcd_barrier(bar); xcd_barrier(bar); } } while (0)
#else
#define SEAM(k) do { if (IN((k) + 1)) xcd_barrier(bar); } while (0)
#endif
#define PHASE(p, BODY) do { if (IN(p)) { if (!W.isw) { BODY; if (F.tid == 0) __hip_atomic_fetch_add((unsigned*)(args.ws + WS_CTL) + 1024 + 64 * (p), 1u, __ATOMIC_RELAXED, __HIP_MEMORY_SCOPE_AGENT); } \
        else worker_phase(F, args, (p), need_before((p) + 1), W.nxt, W.stride, W.nC); SEAM(p); } } while (0)
struct WorkerState { bool isw; int nxt, stride, nC; };
#define PH_BEGIN(p) if (IN(p)) { if (!W.isw) {
#define PH_END(p)   if (F.tid == 0) __hip_atomic_fetch_add((unsigned*)(args.ws + WS_CTL) + 1024 + 64 * (p), 1u, __ATOMIC_RELAXED, __HIP_MEMORY_SCOPE_AGENT); } \
                    else worker_phase(F, args, (p), need_before((p) + 1), W.nxt, W.stride, W.nC); SEAM(p); }
template <int l> __device__ __forceinline__ void layer_body(const Frame& F, const Args& args, const XcdBarrier& bar, const int lo, const int hi, WorkerState& W) {
    unsigned char* ws = args.ws;
    bf16_t* XN = (bf16_t*)(ws + WS_XN); bf16_t* QKV = (bf16_t*)(ws + WS_QKV); bf16_t* Ob = (bf16_t*)(ws + WS_O);
    bf16_t* ACT = (bf16_t*)(ws + WS_ACT); bf16_t* Y = (bf16_t*)(ws + WS_Y); bf16_t* XA = (bf16_t*)(ws + WS_XA); bf16_t* XB = (bf16_t*)(ws + WS_XB); float* logits = (float*)(ws + WS_LOGIT);
    LAS int* idx = (LAS int*)(F.lds + TAB_IDX); LAS int* tile_l = (LAS int*)(F.lds + TAB_TILE);
    const int pb = 1 + l * NPH;
    const float* modl = (const float*)(ws + WS_MOD) + (size_t)l * 4 * MODW;
    const void* xin = (l == 0) ? (const void*)args.in[0] : (const void*)XB;

#if DENSE0_QKV8 && FUSE_N1
#elif DENSE0_QKV8
    if (l == 0) { PH_BEGIN(pb + PH_NORM1) phase_norm_x(F, (const float*)xin, args.in[4] + l * D, modl, 0, 1, ws + WS_XN8); PH_END(pb + PH_NORM1) }
#else
    if (l == 0) { PH_BEGIN(pb + PH_NORM1) phase_norm<false>(F, xin, args.in[4] + l * D, modl, 0, 1, DENSE0_QKV8 ? nullptr : XN, DENSE0_QKV8 ? ws + WS_XN8 : nullptr); PH_END(pb + PH_NORM1) }
#endif
    PH_BEGIN(pb + PH_QKV)
        pg8::StaticOrder So; So.init(T, 3 * D, F.G, F.bid);
        if (l == 0) {
#if DENSE0_QKV8
            pg8::Gemm g{(const bf16_t*)(ws + WS_XN8), (const bf16_t*)(ws + WS_WIN), D / 2, 0, nullptr, D / 2, 0}; pg8::EpiBf16 E{QKV, 3 * D, 1.f / WD_SC};
            pg8::gemm_phase<pg8::EpiBf16, pg8::StaticOrder, false, true>(F.lds, idx, g, So, E);
#else
            pg8::Gemm g{XN, (const bf16_t*)(ws + WS_WIN), D, 0, nullptr, D, 0}; pg8::EpiBf16 E{QKV, 3 * D, 1.f};
            pg8::gemm_phase<pg8::EpiBf16, pg8::StaticOrder, false>(F.lds, idx, g, So, E);
#endif
        } else {
#if DENSE1_FP8
            pg8::Gemm g{(const bf16_t*)(ws + WS_XN8), (const bf16_t*)(ws + WS_WIN8), D / 2, 0, nullptr, D / 2, 0};
            pg8::EpiBf16QK E{QKV, 3 * D, args.in[8], args.in[9], (LAS float*)(F.lds + EPI_OFF), 1.f / WD_SC};
            pg8::gemm_phase<pg8::EpiBf16QK, pg8::StaticOrder, false, true>(F.lds, idx, g, So, E);
#else
            pg8::Gemm g{XN, (const bf16_t*)(ws + WS_WIN) + (size_t)3 * D * D, D, 0, nullptr, D, 0};
            pg8::EpiBf16QK E{QKV, 3 * D, args.in[8], args.in[9], (LAS float*)(F.lds + EPI_OFF), 1.f};
            pg8::gemm_phase<pg8::EpiBf16QK, pg8::StaticOrder, false>(F.lds, idx, g, So, E);
#endif
        }
    PH_END(pb + PH_QKV)
    PH_BEGIN(pb + PH_ATTN)
        if (l == 0) attn_phase_sb(F, args); else attn_phase_da(F, args);
    PH_END(pb + PH_ATTN)
    PH_BEGIN(pb + PH_OUTPROJ)
        pg8::StaticOrder So; So.init(T, D, F.G, F.bid);
        if (l == 0) {
#if DENSE0_OUT8
            pg8::Gemm g{Ob, (const bf16_t*)(ws + WS_WOUT), D / 2, 0, nullptr, D / 2, 0}; pg8::EpiResGate<false> E{xin, XA, modl + 2 * D, 1.f / (WD_SC * O_SC)};
            pg8::gemm_phase<pg8::EpiResGate<false>, pg8::StaticOrder, false, true>(F.lds, idx, g, So, E);
#else
            pg8::Gemm g{Ob, (const bf16_t*)(ws + WS_WOUT), D, 0, nullptr, D, 0}; pg8::EpiResGate<false> E{xin, XA, modl + 2 * D, 1.f};
            pg8::gemm_phase<pg8::EpiResGate<false>, pg8::StaticOrder, false>(F.lds, idx, g, So, E);
#endif
        } else {
#if DENSE1_FP8
            pg8::Gemm g{Ob, (const bf16_t*)(ws + WS_WOUT8), D / 2, 0, nullptr, D / 2, 0}; pg8::EpiResGate<true> E{xin, XA, modl + 2 * D, 1.f / (WD_SC * O_SC)};
            pg8::gemm_phase<pg8::EpiResGate<true>, pg8::StaticOrder, false, true>(F.lds, idx, g, So, E);
#else
            pg8::Gemm g{Ob, (const bf16_t*)(ws + WS_WOUT) + (size_t)D * D, D, 0, nullptr, D, 0}; pg8::EpiResGate<true> E{xin, XA, modl + 2 * D, 1.f};
            pg8::gemm_phase<pg8::EpiResGate<true>, pg8::StaticOrder, false>(F.lds, idx, g, So, E);
#endif
        }
    PH_END(pb + PH_OUTPROJ)
#if FUSE_NRR
    PH_BEGIN(pb + PH_NORM2) phase_nrr(F, args, l, XA, args.in[5] + l * D, modl, ws + WS_XN8); PH_END(pb + PH_NORM2)
#else
    PH_BEGIN(pb + PH_NORM2) phase_norm<true>(F, XA, args.in[5] + l * D, modl, 3, 4, XN, ws + WS_XN8); PH_END(pb + PH_NORM2)
    PH_BEGIN(pb + PH_ROUTER)
        pg8::Gemm g{XN, (const bf16_t*)(ws + WS_WR) + (size_t)l * 256 * D, D / 4, (size_t)(D / 4) * 2, nullptr, D, (size_t)(D / 4) * 2}; pg8::SplitOrder So; So.init(T / 256, F.G, F.bid);
        pg8::EpiRouter E{logits};
        pg8::gemm_phase<pg8::EpiRouter, pg8::SplitOrder, false>(F.lds, idx, g, So, E);
    PH_END(pb + PH_ROUTER)
    PH_BEGIN(pb + PH_ROUTE) phase_route(F, args, l); PH_END(pb + PH_ROUTE)
#endif
    PH_BEGIN(pb + PH_SORT) phase_sort(F, args); PH_END(pb + PH_SORT)
    PH_BEGIN(pb + PH_GEMM1)
        const int* te = (const int*)(ws + WS_TILEE); const int nrt = te[NRT_MAX];
        __syncthreads();
        for (int i = F.tid; i < NRT_MAX; i += NTHREADS) tile_l[i] = (i < nrt) ? te[i] : NE;
        __syncthreads();
        pg8::Gemm g{(const bf16_t*)(ws + WS_XN8), (const bf16_t*)(ws + WS_W1 + (size_t)l * 65 * 1024 * D), D / 2, (size_t)1024 * D, (const int*)(ws + WS_TOK), D / 2, 0};
        pg8::MoeOrder Mo; Mo.init(nrt + 64, 4, F.G, F.bid, tile_l, nrt, NSR / 256);
        pg8::EpiSwiGLU8 E{(unsigned char*)ACT, 1.f / W1_SC, ACT_SC};
        pg8::gemm_phase<pg8::EpiSwiGLU8, pg8::MoeOrder, true, true>(F.lds, idx, g, Mo, E);
    PH_END(pb + PH_GEMM1)
    PH_BEGIN(pb + PH_GEMM2)
        const int* te = (const int*)(ws + WS_TILEE); const int nrt = te[NRT_MAX];
        __syncthreads();
        for (int i = F.tid; i < NRT_MAX; i += NTHREADS) tile_l[i] = (i < nrt) ? te[i] : NE;
        __syncthreads();
        pg8::Gemm g{ACT, (const bf16_t*)(ws + WS_W2 + (size_t)l * 65 * D * EF), EF / 2, (size_t)D * EF, nullptr, EF / 2, 0}; pg8::MoeOrder Mo; Mo.init(nrt + 64, 8, F.G, F.bid, tile_l, nrt, NSR / 256);
        static_assert(Y_SC / (W2_SC * ACT_SC) == 0.0625f && pg8::EpiFp8::SEXP == -4, "GEMM2 output scale is folded into the MFMA block scale");
        pg8::EpiFp8 E{(unsigned char*)Y, D, Y_SC / (W2_SC * ACT_SC)};
        pg8::gemm_phase<pg8::EpiFp8, pg8::MoeOrder, false, true>(F.lds, idx, g, Mo, E);
    PH_END(pb + PH_GEMM2)
    PH_BEGIN(pb + PH_COMBINE)
        if (l == 1) phase_combine_out(F, args, XA, modl, args.out); else
        phase_combine(F, args, XA, modl, l == 0 ? nullptr : args.out, l == 0 ? XB : nullptr, l == 0 ? args.in[4] + D : nullptr, (const float*)(ws + WS_MOD) + (size_t)4 * MODW, DENSE1_FP8 ? nullptr : XN, (l == 0 && DENSE1_FP8) ? ws + WS_XN8 : nullptr);
    PH_END(pb + PH_COMBINE)
}
__global__ void __launch_bounds__(NTHREADS, 2) mega_fwd(Args args) {
    extern __shared__ __attribute__((aligned(16))) unsigned char lds_raw[];
    Frame F; F.lds = (LAS unsigned char*)lds_raw; F.tid = threadIdx.x; F.lane = F.tid & 63; F.wave = __builtin_amdgcn_readfirstlane(F.tid >> 6);
    F.bid = blockIdx.x; F.G = gridDim.x; F.gw = F.bid * NWAVES + F.wave; F.NGW = F.G * NWAVES;
    volatile LAS unsigned* MISC = (volatile LAS unsigned*)(F.lds + MISC_OFF);
    if (F.tid < 32) MISC[F.tid] = 0u;
    if (F.tid == 0) *(volatile LAS int*)(F.lds + TAB_MISC + 512) = 0;
    __syncthreads();
    unsigned char* ws = args.ws;
    unsigned* ctl = (unsigned*)(ws + WS_CTL);
    const int lo = args.ph_lo, hi = args.ph_hi;
    const bool multi = (hi - lo) > 1;
    unsigned* barw = ctl + CW_BAR + args.li * XCD_BAR_WORDS;
    XcdBarrier bar; bar.bar = barw; bar.x = 0; bar.st = nullptr;
    if (multi) bar = xcd_barrier_post(barw, MISC + 8);
    if (IN(0)) { p0_prologue(F, args); SEAM(0); }
    WorkerState W; W.nC = (int)gridDim.x - NWORK; W.isw = (int)blockIdx.x >= W.nC; W.stride = NWORK * NWAVES;
    { const int ww = ((int)blockIdx.x - W.nC) * NWAVES + F.wave, base = need_before(lo > 1 ? lo : 1); W.nxt = base + (((ww - base) % W.stride) + W.stride) % W.stride; }
    F.G = W.nC; F.NGW = W.nC * NWAVES;
    layer_body<0>(F, args, bar, lo, hi, W);
    W.isw = false; W.nC = (int)gridDim.x; F.G = (int)gridDim.x; F.NGW = F.G * NWAVES;
    layer_body<1>(F, args, bar, lo, hi, W);
}
#undef PH_BEGIN
#undef PH_END
#ifndef FAST_DENSE
#define FAST_DENSE 1
#endif
#ifndef FAST_MOE
#define FAST_MOE 1
#endif
#ifndef FAST_SB
#define FAST_SB 1
#endif
#ifndef FAST_DA
#define FAST_DA 1
#endif
#ifndef ONE_LAUNCH
#define ONE_LAUNCH 1
#endif
#define NEED_NAIVE (!(FAST_DENSE && FAST_MOE && FAST_SB && FAST_DA))
#if NEED_NAIVE
__device__ __forceinline__ float bf2f(bf16_t v) { return __uint_as_float((unsigned)v << 16); }
__device__ __forceinline__ bf16_t f2bf(float f) { return (bf16_t)(cvt_pk_bf16(f, 0.f) & 0xffffu); }
__device__ __forceinline__ float silu_f(float v) { return v / (1.f + expf(-v)); }
__device__ __forceinline__ float softplus_f(float z) { return fmaxf(z, 0.f) + log1pf(expf(-fabsf(z))); }
struct NG { const bf16_t* A; const float* Bm; const float* Bs; const float* B2m; const float* B2s; void* C; int M, N, K, lda, ldb, ldc; const int* arow; const int* tile_e; long bstride; const float* R; const float* gate; };
template <int EPI> __global__ __launch_bounds__(256) void k_ngemm(NG p) {
    __shared__ float As[16][68]; __shared__ float Bs[16][68]; __shared__ float Cs[16][68];
    const int m0 = blockIdx.y * 64, n0 = blockIdx.x * 64, tid = threadIdx.x, tx = tid & 15, ty = tid >> 4;
    const float* Bm = p.Bm; const float* B2 = p.B2m;
    if (p.tile_e) { const int rt = m0 >> 8; const int e = (rt >= NSR / 256) ? NE : ((rt < p.tile_e[NRT_MAX]) ? p.tile_e[rt] : -1); if (e < 0) return;
        if (e == NE) { Bm = p.Bs; B2 = p.B2s; } else { Bm += (size_t)e * p.bstride; if (EPI == 3) B2 += (size_t)e * p.bstride; } }
    const int ar = tid >> 2, ak = (tid & 3) * 4; const int arow = p.arow ? p.arow[m0 + ar] : (m0 + ar);
    const bf16_t* Ap = p.A + (size_t)arow * p.lda + ak;
    const int bk = tid >> 4, bn = (tid & 15) * 4; const size_t boff = (size_t)bk * p.ldb + n0 + bn;
    float acc[4][4] = {}, acc2[4][4] = {};
    for (int k0 = 0; k0 < p.K; k0 += 16) {
        const u32x2 a = *(const u32x2*)(Ap + k0); const float4 b = *(const float4*)(Bm + boff + (size_t)k0 * p.ldb);
        float4 c2 = make_float4(0, 0, 0, 0); if (EPI == 3) c2 = *(const float4*)(B2 + boff + (size_t)k0 * p.ldb);
        __syncthreads();
        As[ak + 0][ar] = bf_lo(a.x); As[ak + 1][ar] = bf_hi(a.x); As[ak + 2][ar] = bf_lo(a.y); As[ak + 3][ar] = bf_hi(a.y);
        *(float4*)&Bs[bk][bn] = b; if (EPI == 3) *(float4*)&Cs[bk][bn] = c2;
        __syncthreads();
#pragma unroll
        for (int k = 0; k < 16; ++k) { const float4 av = *(const float4*)&As[k][ty * 4]; const float4 bv = *(const float4*)&Bs[k][tx * 4];
            const float aa[4] = {av.x, av.y, av.z, av.w}, bb[4] = {bv.x, bv.y, bv.z, bv.w};
#pragma unroll
            for (int i = 0; i < 4; ++i)
#pragma unroll
                for (int j = 0; j < 4; ++j) acc[i][j] += aa[i] * bb[j];
            if (EPI == 3) { const float4 cv = *(const float4*)&Cs[k][tx * 4]; const float cc[4] = {cv.x, cv.y, cv.z, cv.w};
#pragma unroll
                for (int i = 0; i < 4; ++i)
#pragma unroll
                    for (int j = 0; j < 4; ++j) acc2[i][j] += aa[i] * cc[j]; } }
    }
#pragma unroll
    for (int i = 0; i < 4; ++i) { const int m = m0 + ty * 4 + i; const int n = n0 + tx * 4;
        if (EPI == 1) { const float4 r = *(const float4*)(p.R + (size_t)m * p.ldc + n); const float4 g = *(const float4*)(p.gate + (size_t)(m / S) * MODW + n);
            *(float4*)((float*)p.C + (size_t)m * p.ldc + n) = make_float4(r.x + g.x * acc[i][0], r.y + g.y * acc[i][1], r.z + g.z * acc[i][2], r.w + g.w * acc[i][3]); }
        else { float v[4];
#pragma unroll
            for (int j = 0; j < 4; ++j) v[j] = (EPI == 3) ? silu_f(acc[i][j]) * acc2[i][j] : acc[i][j];
            u32x2 o; o.x = cvt_pk_bf16(v[0], v[1]); o.y = cvt_pk_bf16(v[2], v[3]); *(u32x2*)((bf16_t*)p.C + (size_t)m * p.ldc + n) = o; } }
}
__global__ void k_nlogits(const bf16_t* __restrict__ XN, const float* __restrict__ w_router, float* __restrict__ logits) {
    const int t = (blockIdx.x * 256 + threadIdx.x) >> 6, lane = threadIdx.x & 63;
    const bf16_t* hr = XN + (size_t)t * D; const float* wr = w_router + (size_t)lane * D; float acc = 0.f;
    for (int k = 0; k < D; k += 4) { const u32x2 a = *(const u32x2*)(hr + k); const float4 w = *(const float4*)(wr + k); acc += bf_lo(a.x) * w.x + bf_hi(a.x) * w.y + bf_lo(a.y) * w.z + bf_hi(a.y) * w.w; }
    logits[(size_t)t * NE + lane] = acc;
}
template <int MODE, int DV>
__global__ __launch_bounds__(256) void k_nattn(const bf16_t* __restrict__ qkv, bf16_t* __restrict__ outb) {
    extern __shared__ float sm[];
    float* Qs = sm; float* Ks = Qs + 64 * 129; float* Vs = Ks + 64 * 129; float* Z = Vs + 64 * DV; float* al = Z + 64 * 65;
    const int qt = blockIdx.x, vh = blockIdx.y, b = blockIdx.z, tid = threadIdx.x, tx = tid & 15, ty = tid >> 4;
    int qcol, kcol, vcol, ocol; float slope = 0.f; bf16_t* out = outb;
    if (MODE == 0) { qcol = vh * 128; kcol = D + vh * 128; vcol = 2 * D + vh * 128; ocol = vh * 128; }
    else { const int h = vh >> 1; qcol = vh * 128; kcol = D + vh * 128; vcol = 2 * D + h * 256; ocol = h * 256; out += (size_t)(vh & 1) * T * D; slope = exp2f(-(float)(h + 1)); }
    const float scale = 0.08838834764831845f; const size_t rowb = (size_t)b * S;
    for (int i = tid; i < 64 * 128; i += 256) { const int r = i >> 7, d = i & 127; Qs[r * 129 + d] = bf2f(qkv[(rowb + qt * 64 + r) * (3 * D) + qcol + d]); }
    constexpr int NC = DV / 16; float acc[4][NC];
#pragma unroll
    for (int i = 0; i < 4; ++i)
#pragma unroll
        for (int c = 0; c < NC; ++c) acc[i][c] = 0.f;
    float carry = 0.f, mrow = -1e30f, lrow = 0.f;
    for (int kt = qt; kt >= 0; --kt) {
        __syncthreads();
        for (int i = tid; i < 64 * 128; i += 256) { const int r = i >> 7, d = i & 127; Ks[r * 129 + d] = bf2f(qkv[(rowb + kt * 64 + r) * (3 * D) + kcol + d]); }
        for (int i = tid; i < 64 * DV; i += 256) { const int r = i / DV, d = i % DV; Vs[r * DV + d] = bf2f(qkv[(rowb + kt * 64 + r) * (3 * D) + vcol + d]); }
        __syncthreads();
        float z[4][4] = {};
        for (int d = 0; d < 128; ++d) { float qa[4], kb[4];
#pragma unroll
            for (int i = 0; i < 4; ++i) { qa[i] = Qs[(ty * 4 + i) * 129 + d]; kb[i] = Ks[(tx * 4 + i) * 129 + d]; }
#pragma unroll
            for (int i = 0; i < 4; ++i)
#pragma unroll
                for (int j = 0; j < 4; ++j) z[i][j] += qa[i] * kb[j]; }
#pragma unroll
        for (int i = 0; i < 4; ++i)
#pragma unroll
            for (int j = 0; j < 4; ++j) Z[(ty * 4 + i) * 65 + tx * 4 + j] = z[i][j] * scale;
        __syncthreads();
        if (tid < 64) { const int tq = qt * 64 + tid; float* zr = Z + tid * 65;
            if (MODE == 0) {
                for (int j = 63; j >= 0; --j) { const int sk = kt * 64 + j; float a = 0.f; if (sk < tq) { const float zz = zr[j], sp = softplus_f(zz); a = expf(zz - sp + carry); carry -= sp; } zr[j] = a; }
                al[tid] = 1.f;
            } else { float mx = -1e30f;
                for (int j = 0; j < 64; ++j) { const int sk = kt * 64 + j; if (sk <= tq) { const float zz = zr[j] - slope * (float)(tq - sk); zr[j] = zz; mx = fmaxf(mx, zz); } }
                const float mn = fmaxf(mrow, mx), alpha = expf(mrow - mn); float ps = 0.f;
                for (int j = 0; j < 64; ++j) { const int sk = kt * 64 + j; float pv = 0.f; if (sk <= tq) { pv = expf(zr[j] - mn); ps += pv; } zr[j] = pv; }
                lrow = lrow * alpha + ps; mrow = mn; al[tid] = alpha; } }
        __syncthreads();
#pragma unroll
        for (int i = 0; i < 4; ++i) { const float a_ = al[ty * 4 + i];
#pragma unroll
            for (int c = 0; c < NC; ++c) acc[i][c] *= a_; }
        for (int j = 0; j < 64; ++j) { float pa[4];
#pragma unroll
            for (int i = 0; i < 4; ++i) pa[i] = Z[(ty * 4 + i) * 65 + j];
#pragma unroll
            for (int c = 0; c < NC; ++c) { const float vv = Vs[j * DV + tx + 16 * c];
#pragma unroll
                for (int i = 0; i < 4; ++i) acc[i][c] += pa[i] * vv; } }
    }
    __syncthreads();
    if (tid < 64) al[tid] = (MODE == 1) ? 1.f / lrow : 1.f;
    __syncthreads();
#pragma unroll
    for (int i = 0; i < 4; ++i) { const float a_ = al[ty * 4 + i];
#pragma unroll
        for (int c = 0; c < NC; ++c) out[(rowb + qt * 64 + ty * 4 + i) * D + ocol + tx + 16 * c] = f2bf(acc[i][c] * a_); }
}
#endif

static bool phase_is_fast(int p) {
    if (p == 0) return true; const int k = (p - 1) % NPH, l = (p - 1) / NPH;
    if (k == PH_QKV || k == PH_OUTPROJ) return FAST_DENSE;
    if (k == PH_ROUTER || k == PH_GEMM1 || k == PH_GEMM2) return FAST_MOE;
    if (k == PH_ATTN) return l == 0 ? FAST_SB : FAST_DA;
    return true;
}

extern "C" void kernel_launch(void* const* d_in, const int* in_sizes, int n_in, void* d_out, int out_size, void* d_ws, size_t ws_size, hipStream_t stream) {
    static int grid = 0;
    if (grid == 0) {
        if (n_in != 23 || in_sizes[0] != T * D || out_size != T * D || ws_size < WS_END) { fprintf(stderr, "kernel_launch: unexpected shapes (n_in %d in0 %d out %d ws %zu, need ws >= %zu)\n", n_in, n_in > 0 ? in_sizes[0] : -1, out_size, ws_size, (size_t)WS_END); grid = -1; return; }
        int dev = 0, cus = 0, per_cu = 0;
        if (hipGetDevice(&dev) != hipSuccess || hipDeviceGetAttribute(&cus, hipDeviceAttributeMultiprocessorCount, dev) != hipSuccess) { grid = -1; return; }
        if (hipFuncSetAttribute((const void*)mega_fwd, hipFuncAttributeMaxDynamicSharedMemorySize, LDS_BYTES) != hipSuccess) { fprintf(stderr, "kernel_launch: hipFuncSetAttribute failed\n"); grid = -1; return; }
        if (hipOccupancyMaxActiveBlocksPerMultiprocessor(&per_cu, (const void*)mega_fwd, NTHREADS, LDS_BYTES) != hipSuccess || per_cu < 1) fprintf(stderr, "kernel_launch: occupancy query says %d\n", per_cu);
        (void)hipGetLastError();
        grid = cus;
        if (grid > 256) grid = 256;
#if NEED_NAIVE
        (void)hipFuncSetAttribute((const void*)k_nattn<0, 128>, hipFuncAttributeMaxDynamicSharedMemorySize, (64 * 129 * 2 + 64 * 128 + 64 * 65 + 64) * 4);
        (void)hipFuncSetAttribute((const void*)k_nattn<1, 256>, hipFuncAttributeMaxDynamicSharedMemorySize, (64 * 129 * 2 + 64 * 256 + 64 * 65 + 64) * 4);
#endif
    }
    if (grid < 0) return;
    if (hipMemsetAsync((char*)d_ws + WS_CTL, 0, ZERO_BYTES, stream) != hipSuccess) { fprintf(stderr, "kernel_launch: memset failed\n"); return; }
    Args a{};
    for (int i = 0; i < 23; ++i) a.in[i] = (const float*)d_in[i];
    a.out = (float*)d_out; a.ws = (unsigned char*)d_ws;
    unsigned char* ws = (unsigned char*)d_ws;
    int lo = 0, nl = 0;
    auto flush = [&](int hi) { if (hi > lo) {
#if ONE_LAUNCH
            a.ph_lo = lo; a.ph_hi = hi; a.li = nl++; hipLaunchKernelGGL(mega_fwd, dim3(grid), dim3(NTHREADS), LDS_BYTES, stream, a);
#else
            for (int p = lo; p < hi; ++p) { a.ph_lo = p; a.ph_hi = p + 1; hipLaunchKernelGGL(mega_fwd, dim3(grid), dim3(NTHREADS), LDS_BYTES, stream, a);
#ifdef REPEAT_MASK
                if ((REPEAT_MASK >> p) & 1ull) { (void)hipMemsetAsync((char*)d_ws + WS_CTL + 256, 0, 4, stream);
                    hipLaunchKernelGGL(mega_fwd, dim3(grid), dim3(NTHREADS), LDS_BYTES, stream, a); }
#endif
            }
#endif
        } };
    for (int p = 0; p < N_PHASES; ++p) {
        if (phase_is_fast(p)) continue;
        flush(p); lo = p + 1;
#if NEED_NAIVE
        const int k = (p - 1) % NPH, l = (p - 1) / NPH;
        const float* modl = (const float*)(ws + WS_MOD) + (size_t)l * 4 * MODW; const float* xin = (l == 0) ? a.in[0] : a.out;
        bf16_t* XN = (bf16_t*)(ws + WS_XN); bf16_t* QKV = (bf16_t*)(ws + WS_QKV); bf16_t* Ob = (bf16_t*)(ws + WS_O); bf16_t* OT = (bf16_t*)(ws + WS_OT);
        bf16_t* ACT = (bf16_t*)(ws + WS_ACT); bf16_t* Y = (bf16_t*)(ws + WS_Y); float* XA = (float*)(ws + WS_XA);
        NG g{};
        if (k == PH_QKV) { g.A = XN; g.Bm = a.in[6] + (size_t)l * D * 3 * D; g.C = QKV; g.M = T; g.N = 3 * D; g.K = D; g.lda = D; g.ldb = 3 * D; g.ldc = 3 * D;
            hipLaunchKernelGGL(k_ngemm<0>, dim3(g.N / 64, g.M / 64), dim3(256), 0, stream, g); }
        else if (k == PH_OUTPROJ) { g.A = Ob; g.Bm = a.in[7] + (size_t)l * D * D; g.C = XA; g.M = T; g.N = D; g.K = D; g.lda = D; g.ldb = D; g.ldc = D; g.R = xin; g.gate = modl + 2 * D;
            hipLaunchKernelGGL(k_ngemm<1>, dim3(g.N / 64, g.M / 64), dim3(256), 0, stream, g); }
        else if (k == PH_ROUTER) { hipLaunchKernelGGL(k_nlogits, dim3(T / 4), dim3(256), 0, stream, XN, a.in[15] + (size_t)l * NE * D, (float*)(ws + WS_LOGIT)); }
        else if (k == PH_GEMM1) { g.A = XN; g.Bm = a.in[17] + (size_t)l * NE * D * EF; g.Bs = a.in[20] + (size_t)l * D * EF; g.B2m = a.in[18] + (size_t)l * NE * D * EF; g.B2s = a.in[21] + (size_t)l * D * EF;
            g.C = ACT; g.M = NS; g.N = EF; g.K = D; g.lda = D; g.ldb = EF; g.ldc = EF; g.arow = (const int*)(ws + WS_TOK); g.tile_e = (const int*)(ws + WS_TILEE); g.bstride = (long)D * EF;
            hipLaunchKernelGGL(k_ngemm<3>, dim3(g.N / 64, g.M / 64), dim3(256), 0, stream, g); }
        else if (k == PH_GEMM2) { g.A = ACT; g.Bm = a.in[19] + (size_t)l * NE * EF * D; g.Bs = a.in[22] + (size_t)l * EF * D; g.C = Y; g.M = NS; g.N = D; g.K = EF; g.lda = EF; g.ldb = D; g.ldc = D;
            g.tile_e = (const int*)(ws + WS_TILEE); g.bstride = (long)EF * D;
            hipLaunchKernelGGL(k_ngemm<0>, dim3(g.N / 64, g.M / 64), dim3(256), 0, stream, g); }
        else if (k == PH_ATTN) {
            if (l == 0) hipLaunchKernelGGL((k_nattn<0, 128>), dim3(S / 64, 16, NB), dim3(256), (64 * 129 * 2 + 64 * 128 + 64 * 65 + 64) * 4, stream, QKV, Ob);
            else hipLaunchKernelGGL((k_nattn<1, 256>), dim3(S / 64, 16, NB), dim3(256), (64 * 129 * 2 + 64 * 256 + 64 * 65 + 64) * 4, stream, QKV, OT); }
#endif
    }
    flush(N_PHASES);
    const hipError_t le = hipPeekAtLastError();
    if (le != hipSuccess) fprintf(stderr, "kernel_launch: launch failed: %s\n", hipGetErrorName(le));
}
```

```cpp
#include <hip/hip_runtime.h>
#include <cstdio>
#include <cstdint>
#define ONE_LAUNCH 1
#define LAS __attribute__((address_space(3)))
#define GAS __attribute__((address_space(1)))
typedef unsigned short bf16_t;
typedef short bf16x8 __attribute__((ext_vector_type(8)));
typedef _Float16 f16x8 __attribute__((ext_vector_type(8)));
typedef float f32x4 __attribute__((ext_vector_type(4)));
typedef float f32x2 __attribute__((ext_vector_type(2)));
typedef float f32x16 __attribute__((ext_vector_type(16)));
typedef unsigned u32x4 __attribute__((ext_vector_type(4)));
typedef unsigned u32x2 __attribute__((ext_vector_type(2)));
typedef short s16x4 __attribute__((ext_vector_type(4)));
typedef int i32x8 __attribute__((ext_vector_type(8)));
typedef int i32x4 __attribute__((ext_vector_type(4)));

constexpr int D = 2048, NB = 4, S = 4096, T = NB * S, NE = 64, TOPK = 6, EF = 512;
constexpr int MODW = 6 * D;
constexpr int NSR = T * TOPK + NE * 256;
constexpr int NS = NSR + T;
constexpr int NRT_MAX = NS / 256;
constexpr float EPS = 1e-6f, SUBLN_EPS = 1e-5f;
constexpr float LOG2E = 1.4426950408889634f;
#ifndef DENSE1_FP8
#define DENSE1_FP8 1
#endif
constexpr float WD_SC = 64.f, O_SC = 4.f;
#ifndef DA_SWPIPE
#define DA_SWPIPE 0
#endif
#ifndef DENSE0_FP8
#define DENSE0_FP8 1
#endif
#ifndef DENSE0_QKV8
#define DENSE0_QKV8 DENSE0_FP8
#endif
#ifndef DENSE0_OUT8
#define DENSE0_OUT8 DENSE0_FP8
#endif

__device__ __forceinline__ unsigned cvt_pk_bf16(float lo, float hi) { unsigned r; asm volatile("v_cvt_pk_bf16_f32 %0, %1, %2" : "=v"(r) : "v"(lo), "v"(hi)); return r; }
__device__ __forceinline__ unsigned pk4_fp8(float a, float b, float c, float d) {
    a = __builtin_amdgcn_fmed3f(a, -448.f, 448.f); b = __builtin_amdgcn_fmed3f(b, -448.f, 448.f); c = __builtin_amdgcn_fmed3f(c, -448.f, 448.f); d = __builtin_amdgcn_fmed3f(d, -448.f, 448.f);
    int r = 0; r = __builtin_amdgcn_cvt_pk_fp8_f32(a, b, r, false); r = __builtin_amdgcn_cvt_pk_fp8_f32(c, d, r, true); return (unsigned)r; }
__device__ __forceinline__ float bf_lo(unsigned w) { return __uint_as_float(w << 16); }
__device__ __forceinline__ float bf_hi(unsigned w) { return __uint_as_float(w & 0xffff0000u); }
__device__ __forceinline__ float wave_sum(float v) {
#pragma unroll
    for (int o = 1; o < 64; o <<= 1) v += __shfl_xor(v, o);
    return v;
}

namespace pg8 {
constexpr int BM = 256, BK = 64, HALF = 128, HTB = HALF * BK * 2  , STAGE_BYTES = 8 * HTB, NXCD = 8, WGM = 8;
__host__ __device__ __forceinline__ int lds_byte(int r, int c) { const int st = (r >> 4) * 2 + (c >> 5), rr = r & 15, cc = c & 31, ob = rr * 64 + cc * 2; return st * 1024 + (ob ^ (((ob >> 9) & 1) << 5)); }
__host__ __device__ __forceinline__ void stage_rc(int b, int& R, int& C) { const int st = b / 1024, sb = b % 1024, swz = sb ^ (((sb >> 9) & 1) << 5); R = (st >> 1) * 16 + swz / 64; C = (st & 1) * 32 + (swz % 64) / 2; }
__host__ __device__ __forceinline__ int perm32(int rho) { const int n = rho >> 4, i = rho & 15; return 8 * (i >> 2) + 4 * n + (i & 3); }

struct Unit { int pm, pn, be; };
struct Gemm { const bf16_t* A; const bf16_t* Bt; int K; size_t bstride; const int* gather; int ld; size_t astride; };

struct StaticOrder {
    int nM, nN, nwg, G, c;
    __device__ void init(int M, int N, int G_, int c_) { nM = M / BM; nN = N / BM; nwg = nM * nN; G = G_; c = c_; }
    __device__ bool next(int i, Unit& u) const {
        const long L = (long)i * G + c; if (L >= nwg) return false;
        int wgid = (int)L; { const int q = nwg / NXCD, r = nwg % NXCD, xcd = wgid % NXCD, off = wgid / NXCD; wgid = (xcd < r ? xcd * (q + 1) : r * (q + 1) + (xcd - r) * q) + off; }
        const int nig = WGM * nN, gid = wgid / nig, fm = gid * WGM, gsz = (nM - fm) < WGM ? (nM - fm) : WGM;
        u.pm = fm + ((wgid % nig) % gsz); u.pn = (wgid % nig) / gsz; u.be = 0; return true;
    }
};
struct SplitOrder {
    int n, G, c;
    __device__ void init(int nM, int G_, int c_) { n = nM * 4; G = G_; c = c_; }
    __device__ bool next(int i, Unit& u) const { const int id = c + i * G; if (id >= n) return false; u.pm = id >> 2; u.be = id & 3; u.pn = 0; return true; }
};
struct MoeOrder {
    int npn, n, q, G8, x, j0, nrt, sbase, per;
    const LAS int* tile_e;
    __device__ void init(int ntiles, int npn_, int G, int c, const LAS int* te, int nrt_, int sbase_) { npn = npn_; n = ntiles * npn; q = (n + 7) / 8; G8 = G / 8; x = c % 8; j0 = c / 8; tile_e = te; nrt = nrt_; sbase = sbase_; per = (q + G8 - 1) / G8; }
    __device__ bool next(int i, Unit& u) const {
#ifdef MOE_CONTIG
        if (i >= per) return false; const int j = j0 * per + i; if (j >= q) return false; const int id = x * q + j; if (id >= n) return false;
#else
        const int j = j0 + i * G8; if (j >= q) return false; const int id = x * q + j; if (id >= n) return false;
#endif
        const int ct = id / npn; u.pn = id % npn; u.pm = ct < nrt ? ct : sbase + (ct - nrt); u.be = tile_e[u.pm]; return true;
    }
};

struct EpiBf16 {
    static constexpr int PERM = 2; static constexpr bool NOMMA = false; static constexpr int SEXP = 0, NSTORES = 16;
    bf16_t* O; int ldc; float sc;
    __device__ __forceinline__ void operator()(const f32x4 (&acc)[2][2][4][2], const Unit& u, int wr, int wc, int fr, int fq) const {
        const int row0 = u.pm * BM + wr * 64 + fr; const int col0 = u.pn * BM + wc * 64 + 16 * fq;
#pragma unroll
        for (int ai = 0; ai < 2; ++ai)
#pragma unroll
            for (int m = 0; m < 4; ++m) { bf16_t* rowp = O + (size_t)(row0 + ai * HALF + m * 16) * ldc + col0;
                const f32x4 v0 = acc[ai][0][m][0] * sc, v1 = acc[ai][0][m][1] * sc, v2 = acc[ai][1][m][0] * sc, v3 = acc[ai][1][m][1] * sc;
                u32x4 w0, w1; w0.x = cvt_pk_bf16(v0[0], v0[1]); w0.y = cvt_pk_bf16(v0[2], v0[3]); w0.z = cvt_pk_bf16(v1[0], v1[1]); w0.w = cvt_pk_bf16(v1[2], v1[3]);
                w1.x = cvt_pk_bf16(v2[0], v2[1]); w1.y = cvt_pk_bf16(v2[2], v2[3]); w1.z = cvt_pk_bf16(v3[0], v3[1]); w1.w = cvt_pk_bf16(v3[2], v3[3]);
                *(u32x4*)rowp = w0; *(u32x4*)(rowp + 8) = w1; }
    }
};
struct EpiBf16QK {
    static constexpr int PERM = 2; static constexpr bool NOMMA = false; static constexpr int SEXP = 0, NSTORES = 16;
    bf16_t* O; int ldc; const float* qn; const float* kn; LAS float* xch; float sc;
    __device__ __forceinline__ void operator()(const f32x4 (&acc)[2][2][4][2], const Unit& u, int wr, int wc, int fr, int fq) const {
        const int row0 = u.pm * BM + wr * 64 + fr; const int col0 = u.pn * BM + wc * 64 + 16 * fq;
        const bool qk = u.pn < 16;
        int fr_ = fr; asm volatile("" : "+v"(fr_));
        LAS float* xb = xch + (wr * 64 + fr_) * 4;
        if (qk) {
#pragma unroll
            for (int ai = 0; ai < 2; ++ai)
#pragma unroll
                for (int m = 0; m < 4; ++m) { float s_ = 0.f;
#pragma unroll
                    for (int q = 0; q < 4; ++q) { const f32x4 v = acc[ai][q >> 1][m][q & 1]; s_ += v[0] * v[0] + v[1] * v[1] + v[2] * v[2] + v[3] * v[3]; }
                    s_ += __shfl_xor(s_, 16); s_ += __shfl_xor(s_, 32);
                    if (fq == 0) xb[(ai * HALF + m * 16) * 4 + wc] = s_; }
            asm volatile("s_waitcnt lgkmcnt(0)" ::: "memory"); __builtin_amdgcn_s_barrier(); asm volatile("" ::: "memory");
        }
        f32x4 gw[4];
#pragma unroll
        for (int q = 0; q < 4; ++q) gw[q] = qk ? *(const f32x4*)((u.pn < 8 ? qn : kn) + (wc & 1) * 64 + 16 * fq + 4 * q) : (f32x4){1.f, 1.f, 1.f, 1.f};
#pragma unroll
        for (int ai = 0; ai < 2; ++ai)
#pragma unroll
            for (int m = 0; m < 4; ++m) { bf16_t* rowp = O + (size_t)(row0 + ai * HALF + m * 16) * ldc + col0; float r = sc;
                if (qk) { const LAS float* pp = xb + (ai * HALF + m * 16) * 4 + (wc & 2); r = rsqrtf((pp[0] + pp[1]) * (sc * sc * (1.f / 128.f)) + EPS) * sc; }
                const f32x4 v0 = acc[ai][0][m][0] * r * gw[0], v1 = acc[ai][0][m][1] * r * gw[1], v2 = acc[ai][1][m][0] * r * gw[2], v3 = acc[ai][1][m][1] * r * gw[3];
                u32x4 w0, w1; w0.x = cvt_pk_bf16(v0[0], v0[1]); w0.y = cvt_pk_bf16(v0[2], v0[3]); w0.z = cvt_pk_bf16(v1[0], v1[1]); w0.w = cvt_pk_bf16(v1[2], v1[3]);
                w1.x = cvt_pk_bf16(v2[0], v2[1]); w1.y = cvt_pk_bf16(v2[2], v2[3]); w1.z = cvt_pk_bf16(v3[0], v3[1]); w1.w = cvt_pk_bf16(v3[2], v3[3]);
                *(u32x4*)rowp = w0; *(u32x4*)(rowp + 8) = w1; }
    }
};
template <bool RBF> struct EpiResGate { static constexpr int SEXP = 0, NSTORES = 16;
    static constexpr int PERM = 2; static constexpr bool NOMMA = false;
    const void* R; bf16_t* out; const float* gate; float sc;
    __device__ __forceinline__ void operator()(const f32x4 (&acc)[2][2][4][2], const Unit& u, int wr, int wc, int fr, int fq) const {
        const int row0 = u.pm * BM + wr * 64 + fr, col0 = u.pn * BM + wc * 64 + 16 * fq;
        const float* gp = gate + (size_t)((u.pm * BM) / S) * MODW + col0;
        f32x4 gv[4];
#pragma unroll
        for (int q = 0; q < 4; ++q) gv[q] = *(const f32x4*)(gp + 4 * q) * sc;
#pragma unroll
        for (int ai = 0; ai < 2; ++ai)
#pragma unroll
            for (int m = 0; m < 4; ++m) { const size_t off = (size_t)(row0 + ai * HALF + m * 16) * D + col0; f32x4 r[4];
                if (RBF) { const u32x4 w0 = *(const u32x4*)((const bf16_t*)R + off), w1 = *(const u32x4*)((const bf16_t*)R + off + 8);
                    r[0] = (f32x4){bf_lo(w0.x), bf_hi(w0.x), bf_lo(w0.y), bf_hi(w0.y)}; r[1] = (f32x4){bf_lo(w0.z), bf_hi(w0.z), bf_lo(w0.w), bf_hi(w0.w)};
                    r[2] = (f32x4){bf_lo(w1.x), bf_hi(w1.x), bf_lo(w1.y), bf_hi(w1.y)}; r[3] = (f32x4){bf_lo(w1.z), bf_hi(w1.z), bf_lo(w1.w), bf_hi(w1.w)}; }
                else {
#pragma unroll
                    for (int q = 0; q < 4; ++q) r[q] = *(const f32x4*)((const float*)R + off + 4 * q); }
#pragma unroll
                for (int q = 0; q < 4; ++q) r[q] = r[q] + gv[q] * acc[ai][q >> 1][m][q & 1];
                u32x4 o0, o1; o0.x = cvt_pk_bf16(r[0][0], r[0][1]); o0.y = cvt_pk_bf16(r[0][2], r[0][3]); o0.z = cvt_pk_bf16(r[1][0], r[1][1]); o0.w = cvt_pk_bf16(r[1][2], r[1][3]);
                o1.x = cvt_pk_bf16(r[2][0], r[2][1]); o1.y = cvt_pk_bf16(r[2][2], r[2][3]); o1.z = cvt_pk_bf16(r[3][0], r[3][1]); o1.w = cvt_pk_bf16(r[3][2], r[3][3]);
                *(u32x4*)(out + off) = o0; *(u32x4*)(out + off + 8) = o1; }
    }
};
struct EpiRouter {
    static constexpr int PERM = 0; static constexpr bool NOMMA = false; static constexpr int SEXP = 0, NSTORES = 0;
    float* out;
    __device__ __forceinline__ void operator()(const f32x4 (&acc)[2][2][4][2], const Unit& u, int wr, int wc, int fr, int fq) const {
        if (wc >= 2) return;
        const int row0 = u.pm * BM + wr * 64 + fr, col0 = wc * 32 + 4 * fq;
#pragma unroll
        for (int ai = 0; ai < 2; ++ai)
#pragma unroll
            for (int m = 0; m < 4; ++m)
#pragma unroll
                for (int n = 0; n < 2; ++n) *(f32x4*)(out + ((size_t)u.be * T + row0 + ai * HALF + m * 16) * NE + col0 + n * 16) = acc[ai][0][m][n];
    }
};
__device__ __forceinline__ float silu_mul(float g, float u) { return g * u * __builtin_amdgcn_rcpf(1.f + __builtin_amdgcn_exp2f(-g * LOG2E)); }
struct EpiSwiGLU {
    static constexpr int PERM = 1; static constexpr bool NOMMA = false; static constexpr int SEXP = 0, NSTORES = 8;
    bf16_t* O;
    __device__ __forceinline__ void operator()(const f32x4 (&acc)[2][2][4][2], const Unit& u, int wr, int wc, int fr, int fq) const {
        const int row0 = u.pm * BM + wr * 64 + fr; const int col0 = u.pn * HALF + wc * 32 + 8 * fq;
#pragma unroll
        for (int ai = 0; ai < 2; ++ai)
#pragma unroll
            for (int m = 0; m < 4; ++m) { const f32x4 g0 = acc[ai][0][m][0], g1 = acc[ai][0][m][1], u0 = acc[ai][1][m][0], u1 = acc[ai][1][m][1];
                u32x4 w; w.x = cvt_pk_bf16(silu_mul(g0[0], u0[0]), silu_mul(g0[1], u0[1])); w.y = cvt_pk_bf16(silu_mul(g0[2], u0[2]), silu_mul(g0[3], u0[3]));
                w.z = cvt_pk_bf16(silu_mul(g1[0], u1[0]), silu_mul(g1[1], u1[1])); w.w = cvt_pk_bf16(silu_mul(g1[2], u1[2]), silu_mul(g1[3], u1[3]));
                *(u32x4*)(O + (size_t)(row0 + ai * HALF + m * 16) * EF + col0) = w; }
    }
};

struct EpiNull { static constexpr int PERM = 1; static constexpr bool NOMMA = false; __device__ __forceinline__ void operator()(const f32x4 (&acc)[2][2][4][2], const Unit& u, int wr, int wc, int fr, int fq) const {} };
struct EpiNullNoMma { static constexpr int PERM = 1; static constexpr bool NOMMA = true; static constexpr int SEXP = 0, NSTORES = 0; __device__ __forceinline__ void operator()(const f32x4 (&acc)[2][2][4][2], const Unit& u, int wr, int wc, int fr, int fq) const {} };
struct EpiFp8 {
    static constexpr int PERM = 2; static constexpr bool NOMMA = false; static constexpr int SEXP = -4, NSTORES = 8;
    unsigned char* O; int ldc; float sc;
    __device__ __forceinline__ void operator()(const f32x4 (&acc)[2][2][4][2], const Unit& u, int wr, int wc, int fr, int fq) const {
        const int row0 = u.pm * BM + wr * 64 + fr; const int col0 = u.pn * BM + wc * 64 + 16 * fq;
#pragma unroll
        for (int ai = 0; ai < 2; ++ai)
#pragma unroll
            for (int m = 0; m < 4; ++m) { const f32x4 v0 = acc[ai][0][m][0], v1 = acc[ai][0][m][1], v2 = acc[ai][1][m][0], v3 = acc[ai][1][m][1];
                u32x4 w; w.x = pk4_fp8(v0[0], v0[1], v0[2], v0[3]); w.y = pk4_fp8(v1[0], v1[1], v1[2], v1[3]); w.z = pk4_fp8(v2[0], v2[1], v2[2], v2[3]); w.w = pk4_fp8(v3[0], v3[1], v3[2], v3[3]);
                *(u32x4*)(O + (size_t)(row0 + ai * HALF + m * 16) * ldc + col0) = w; }
    }
};
struct EpiSwiGLU8 {
    static constexpr int PERM = 1; static constexpr bool NOMMA = false; static constexpr int SEXP = 0, NSTORES = 8;
    unsigned char* O; float isc, osc;
    __device__ __forceinline__ void operator()(const f32x4 (&acc)[2][2][4][2], const Unit& u, int wr, int wc, int fr, int fq) const {
        const int row0 = u.pm * BM + wr * 64 + fr; const int col0 = u.pn * HALF + wc * 32 + 8 * fq;
#pragma unroll
        for (int ai = 0; ai < 2; ++ai)
#pragma unroll
            for (int m = 0; m < 4; ++m) { const f32x4 g0 = acc[ai][0][m][0] * isc, g1 = acc[ai][0][m][1] * isc, u0 = acc[ai][1][m][0] * (isc * osc), u1 = acc[ai][1][m][1] * (isc * osc);
                u32x2 w; w.x = pk4_fp8(silu_mul(g0[0], u0[0]), silu_mul(g0[1], u0[1]), silu_mul(g0[2], u0[2]), silu_mul(g0[3], u0[3]));
                w.y = pk4_fp8(silu_mul(g1[0], u1[0]), silu_mul(g1[1], u1[1]), silu_mul(g1[2], u1[2]), silu_mul(g1[3], u1[3]));
                *(u32x2*)(O + (size_t)(row0 + ai * HALF + m * 16) * EF + col0) = w; }
    }
};

template <class Epi, class Sched, bool GATHER, bool FP8 = false>
__device__ __forceinline__ void gemm_phase(LAS unsigned char* lds, LAS int* idx, const Gemm g, const Sched& S, const Epi& E) {
    const int tid = threadIdx.x, wid = __builtin_amdgcn_readfirstlane(tid >> 6), lane = tid & 63, wr = wid >> 2, wc = wid & 3, fr = lane & 15, fq = lane >> 4;
    int K_ = g.K; asm volatile("" : "+s"(K_));
    const int K = K_, nt = K / BK; int LD_ = g.ld; asm volatile("" : "+s"(LD_)); const int LD = LD_;
    unsigned voffA[2], voffB[2];
#pragma unroll
    for (int i = 0; i < 2; ++i) { int R, C; stage_rc(tid * 16 + i * 8192, R, C); const int rho_ = R & 31;
        const int Rb = Epi::PERM == 1 ? ((R & ~31) + perm32(rho_)) : Epi::PERM == 2 ? ((R >> 5) * 64 + ((rho_ & 15) >> 2) * 16 + (rho_ >> 4) * 4 + (rho_ & 3)) : R;
        voffA[i] = (unsigned)(R * LD + C) * 2u; voffB[i] = (unsigned)(Rb * LD + C) * 2u; }
    const size_t kstep = (size_t)(BK * 2);
    const size_t hstep = (size_t)HALF * LD * 2;
    const size_t tstep = 2 * hstep;
    const size_t hstepB = Epi::PERM == 2 ? (size_t)8 * LD * 2 : hstep;
    const unsigned ldsw = (unsigned)wid * 1024u;
    const int aoff = lds_byte(wr * 64 + fr, fq * 8), boff = lds_byte(wc * 32 + fr, fq * 8);
    const unsigned rowB = (unsigned)LD * 2u;
#define PG8_SA(b, h) (((b) * 2 + (h)) * HTB)
#define PG8_SB(b, h) ((4 + (b) * 2 + (h)) * HTB)
#define PG8_STAGE(bufoff, gbase, voff) do { _Pragma("unroll") for (int _i = 0; _i < 2; ++_i) \
        __builtin_amdgcn_global_load_lds((const unsigned*)((const char*)(gbase) + (voff)[_i]), (LAS unsigned*)(lds + (bufoff) + ldsw + _i * 8192), 16, 0, 0); } while (0)
#define PG8_STAGEA(bufoff, h, ap, kb, go) do { if constexpr (GATHER) { PG8_STAGE(bufoff, (const char*)g.A + (kb), go[h]); } else { PG8_STAGE(bufoff, (ap) + (h) * hstep, voffA); } } while (0)
#define PG8_LD16(off) (*(const LAS i32x4*)(lds + (off)))
#define PG8_LDA(dst, b, h) do { if constexpr (FP8) { _Pragma("unroll") for (int m = 0; m < 4; ++m) dst##8[m] = __builtin_shufflevector(PG8_LD16(PG8_SA(b, h) + aoff + m * 2048), PG8_LD16(PG8_SA(b, h) + aoff + m * 2048 + 1024), 0, 1, 2, 3, 4, 5, 6, 7); } \
    else { _Pragma("unroll") for (int m = 0; m < 4; ++m) _Pragma("unroll") for (int k = 0; k < 2; ++k) dst[m][k] = *(const LAS bf16x8*)(lds + PG8_SA(b, h) + aoff + m * 2048 + k * 1024); } } while (0)
#define PG8_LDB(dst, b, h) do { if constexpr (FP8) { _Pragma("unroll") for (int n = 0; n < 2; ++n) dst##8[n] = __builtin_shufflevector(PG8_LD16(PG8_SB(b, h) + boff + n * 2048), PG8_LD16(PG8_SB(b, h) + boff + n * 2048 + 1024), 0, 1, 2, 3, 4, 5, 6, 7); } \
    else { _Pragma("unroll") for (int n = 0; n < 2; ++n) _Pragma("unroll") for (int k = 0; k < 2; ++k) dst[n][k] = *(const LAS bf16x8*)(lds + PG8_SB(b, h) + boff + n * 2048 + k * 1024); } } while (0)
#define PG8_MMA(ai, bj, At, Bt) do { if constexpr (Epi::NOMMA) { asm volatile("" :: "v"(At[0][0]), "v"(Bt[0][0]), "v"(At[3][1]), "v"(Bt[1][1])); break; } PG8_PRIO(1); if constexpr (FP8) { _Pragma("unroll") for (int m = 0; m < 4; ++m) _Pragma("unroll") for (int n = 0; n < 2; ++n) \
            asm volatile("v_mfma_scale_f32_16x16x128_f8f6f4 %0, %1, %2, %0, %3, %4 op_sel_hi:[0,0,0]" : "+v"(acc[ai][bj][m][n]) : "v"(Bt##8[n]), "v"(At##8[m]), "v"(one_scale), "v"(epi_scale)); } \
        else { _Pragma("unroll") for (int m = 0; m < 4; ++m) _Pragma("unroll") for (int n = 0; n < 2; ++n) _Pragma("unroll") for (int k = 0; k < 2; ++k) \
        acc[ai][bj][m][n] = __builtin_amdgcn_mfma_f32_16x16x32_bf16(Bt[n][k], At[m][k], acc[ai][bj][m][n], 0, 0, 0); } PG8_PRIO(0); } while (0)
#ifdef GEMM_STATIC_PRIO
#define PG8_PRIO(x) do {} while (0)
#else
#define PG8_PRIO(x) __builtin_amdgcn_s_setprio(x)
#endif
#define PG8_WAIT_V(n) asm volatile("s_waitcnt vmcnt(" #n ")" ::: "memory")
#define PG8_WAIT_L(n) asm volatile("s_waitcnt lgkmcnt(" #n ")" ::: "memory")
#define PG8_WAIT_V8R() do { if (relax) { if (GATHER && wid == 0 && has_next) asm volatile("s_waitcnt vmcnt(%0)" :: "n"(9 + Epi::NSTORES) : "memory"); else asm volatile("s_waitcnt vmcnt(%0)" :: "n"(8 + Epi::NSTORES) : "memory"); } else PG8_WAIT_V(8); } while (0)
#define PG8_BAR __builtin_amdgcn_s_barrier()
#define PG8_SCHED __builtin_amdgcn_sched_barrier(0)
    Unit cur, nxt; int ui = 0;
    if (!S.next(0, cur)) return;
#ifdef GEMM_STATIC_PRIO
    if (wr == 1) __builtin_amdgcn_s_setprio(1);
#endif
    f32x4 acc[2][2][4][2];
#pragma unroll
    for (int a = 0; a < 2; ++a)
#pragma unroll
        for (int b = 0; b < 2; ++b)
#pragma unroll
            for (int m = 0; m < 4; ++m)
#pragma unroll
                for (int n = 0; n < 2; ++n) acc[a][b][m][n] = (f32x4){0.f, 0.f, 0.f, 0.f};
    bf16x8 At[4][2], B0[2][2], B1[2][2]; i32x8 At8[4], B08[2], B18[2];
    const unsigned epi_scale = 0x01010101u * (unsigned)(127 + Epi::SEXP);
    const unsigned one_scale = 0x7f7f7f7fu;
    const char* cA = (const char*)g.A + (GATHER ? (size_t)0 : (size_t)cur.pm * tstep + (size_t)cur.be * g.astride);
    const char* cB = (const char*)g.Bt + (size_t)cur.be * g.bstride + (size_t)cur.pn * tstep;
    unsigned gc[2][2] = {{0u, 0u}, {0u, 0u}};
#define PG8_GIDX(dst, base) do { _Pragma("unroll") for (int i = 0; i < 2; ++i) { int R_, C_; stage_rc(tid * 16 + i * 8192, R_, C_); _Pragma("unroll") for (int h = 0; h < 2; ++h) dst[h][i] = (unsigned)idx[(base) + h * HALF + R_] * rowB + (unsigned)C_ * 2u; } } while (0)
    if constexpr (GATHER) {
        if (wid == 0) __builtin_amdgcn_global_load_lds((const unsigned*)(g.gather + (size_t)cur.pm * BM + lane * 4), (LAS unsigned*)idx, 16, 0, 0);
        PG8_WAIT_V(0); PG8_BAR;
        PG8_GIDX(gc, 0);
        PG8_WAIT_L(0); PG8_BAR;
    }
    PG8_STAGE(PG8_SB(0, 0), cB, voffB); PG8_STAGE(PG8_SB(0, 1), cB + hstepB, voffB); PG8_STAGEA(PG8_SA(0, 0), 0, cA, 0, gc); PG8_STAGEA(PG8_SA(0, 1), 1, cA, 0, gc);
    if (wr == 1) PG8_BAR;
    PG8_WAIT_V(2); PG8_BAR;
    PG8_STAGE(PG8_SB(1, 0), cB + kstep, voffB); PG8_STAGEA(PG8_SA(1, 0), 0, cA + kstep, kstep, gc); PG8_STAGE(PG8_SB(1, 1), cB + hstepB + kstep, voffB);
    PG8_WAIT_V(6); PG8_BAR;
    for (;;) {
        const bool has_next = S.next(ui + 1, nxt);
        const char* nA = (has_next && !GATHER) ? (const char*)g.A + (size_t)nxt.pm * tstep + (size_t)nxt.be * g.astride : cA;
        const char* nB = has_next ? (const char*)g.Bt + (size_t)nxt.be * g.bstride + (size_t)nxt.pn * tstep : cB;
        if constexpr (GATHER) {
            if (has_next && wid == 0) __builtin_amdgcn_global_load_lds((const unsigned*)(g.gather + (size_t)nxt.pm * BM + lane * 4), (LAS unsigned*)(idx + ((ui + 1) & 1) * BM), 16, 0, 0);
        }
        int t = 0;
        do {
            const bool last = (t == nt - 2);
            const char* a1 = cA + (size_t)(t + 1) * kstep;
            const char* a2 = last ? nA : cA + (size_t)(t + 2) * kstep; const char* b2 = last ? nB : cB + (size_t)(t + 2) * kstep;
            const char* a3 = a2 + kstep; const char* b3 = b2 + kstep;
            const size_t k1 = (size_t)(t + 1) * kstep, k2 = last ? (size_t)0 : (size_t)(t + 2) * kstep, k3 = k2 + kstep;
            unsigned g2[2][2];
#pragma unroll
            for (int h = 0; h < 2; ++h)
#pragma unroll
                for (int i = 0; i < 2; ++i) g2[h][i] = gc[h][i];
            if constexpr (GATHER) { if (last && has_next) PG8_GIDX(g2, ((ui + 1) & 1) * BM); }
            const int relax = __builtin_amdgcn_readfirstlane(((t == 0) && (ui > 0)) ? 1 : 0);
            PG8_LDB(B0, 0, 0); PG8_LDB(B1, 0, 1); PG8_SCHED; PG8_LDA(At, 0, 0); PG8_STAGEA(PG8_SA(1, 1), 1, a1, k1, gc);
            PG8_WAIT_V8R(); PG8_WAIT_L(0); PG8_BAR; PG8_MMA(0, 0, At, B0); PG8_MMA(0, 1, At, B1); PG8_BAR; PG8_SCHED;
            PG8_LDA(At, 0, 1); PG8_STAGE(PG8_SB(0, 0), b2, voffB); PG8_STAGE(PG8_SB(0, 1), b2 + hstepB, voffB); PG8_STAGEA(PG8_SA(0, 0), 0, a2, k2, g2);
            PG8_WAIT_V8R(); PG8_WAIT_L(0); PG8_BAR; PG8_MMA(1, 0, At, B0); PG8_MMA(1, 1, At, B1); PG8_BAR; PG8_SCHED;
            PG8_LDB(B0, 1, 0); PG8_LDB(B1, 1, 1); PG8_SCHED; PG8_LDA(At, 1, 0); PG8_STAGEA(PG8_SA(0, 1), 1, a2, k2, g2);
            PG8_WAIT_V(8); PG8_WAIT_L(0); PG8_BAR; PG8_MMA(0, 0, At, B0); PG8_MMA(0, 1, At, B1); PG8_BAR; PG8_SCHED;
            PG8_LDA(At, 1, 1); PG8_STAGE(PG8_SB(1, 0), b3, voffB); PG8_STAGE(PG8_SB(1, 1), b3 + hstepB, voffB); PG8_STAGEA(PG8_SA(1, 0), 0, a3, k3, g2);
            PG8_WAIT_V(8); PG8_WAIT_L(0); PG8_BAR; PG8_MMA(1, 0, At, B0); PG8_MMA(1, 1, At, B1); PG8_BAR; PG8_SCHED;
            if constexpr (GATHER) { if (last) { _Pragma("unroll") for (int h = 0; h < 2; ++h) _Pragma("unroll") for (int i = 0; i < 2; ++i) gc[h][i] = g2[h][i]; } }
            t += 2;
        } while (t < nt);
        if (wr == 0) PG8_BAR;
        if constexpr (FP8) asm volatile("s_nop 15\n\ts_nop 7" ::: "memory");
        E(acc, cur, wr, wc, fr, fq);
#ifdef PROBE_EPI2
        E(acc, cur, wr, wc, fr, fq);
#endif
        if (!has_next) break;
#pragma unroll
        for (int a = 0; a < 2; ++a)
#pragma unroll
            for (int b = 0; b < 2; ++b)
#pragma unroll
                for (int m = 0; m < 4; ++m)
#pragma unroll
                    for (int n = 0; n < 2; ++n) acc[a][b][m][n] = (f32x4){0.f, 0.f, 0.f, 0.f};
        cur = nxt; cA = nA; cB = nB; ++ui;
        if (wr == 1) PG8_BAR;
    }
    PG8_WAIT_V(0);
    PG8_BAR;
#ifdef GEMM_STATIC_PRIO
    __builtin_amdgcn_s_setprio(0);
#endif
#undef PG8_SA
#undef PG8_SB
#undef PG8_STAGE
#undef PG8_STAGEA
#undef PG8_GIDX
#undef PG8_LD16
#undef PG8_LDA
#undef PG8_LDB
#undef PG8_MMA
#undef PG8_PRIO
#undef PG8_WAIT_V
#undef PG8_WAIT_V8R
#undef PG8_WAIT_L
#undef PG8_BAR
#undef PG8_SCHED
}
}
namespace att {
constexpr int LDQ = 3 * D;
constexpr int KVBLK = 64, SHM_T = KVBLK * 128 * 2;
constexpr int L_V = 0, L_K = 2 * SHM_T, L_WS = 4 * SHM_T, L_FLAG = L_WS + 8 * 64 * 4, ATT_LDS = L_FLAG + 64;
constexpr float QK_C = 0.08838834764831845f * LOG2E;
#define KSWZ(row, colB) ((row) * 256 + ((colB) ^ (((row) & 7) << 4)))
#define SBAR() __builtin_amdgcn_sched_barrier(0)
__device__ __forceinline__ int crow(int r, int hi) { return (r & 3) + 8 * (r >> 2) + 4 * hi; }
__device__ __forceinline__ int v_st(int k, int c) { const int kk = (k & ~0xC) | ((k & 4) << 1) | ((k & 8) >> 1); return ((kk >> 3) * 4 + (c >> 5)) * 512 + ((kk & 7) * 32 + (c & 31)) * 2; }
__device__ __forceinline__ int v_rd_base(int lane) { return ((lane & 3) << 3) | (((lane >> 2) & 3) << 6) | (((lane >> 4) & 1) << 5) | (((lane >> 5) & 1) << 8); }
constexpr int v_rd_off(int d0, int ks, int half) { return d0 * 512 + ks * 4096 + half * 2048; }
template <int OFF> __device__ __forceinline__ s16x4 tr_read(int vb) { s16x4 r; asm volatile("ds_read_b64_tr_b16 %0, %1 offset:%2" : "=&v"(r) : "v"(vb), "i"(OFF) : "memory"); return r; }
template <int D0> __device__ __forceinline__ void pv_one(f32x16& od, int vb, bf16x8 pa0, bf16x8 pa1, bf16x8 pa2, bf16x8 pa3) {
#define PK(L, H) (bf16x8){L[0], L[1], L[2], L[3], H[0], H[1], H[2], H[3]}
    { const s16x4 l0 = tr_read<v_rd_off(D0, 0, 0)>(vb), h0 = tr_read<v_rd_off(D0, 0, 1)>(vb), l1 = tr_read<v_rd_off(D0, 1, 0)>(vb), h1 = tr_read<v_rd_off(D0, 1, 1)>(vb);
      asm volatile("s_waitcnt lgkmcnt(0)" ::: "memory"); SBAR();
      od = __builtin_amdgcn_mfma_f32_32x32x16_bf16(pa0, PK(l0, h0), od, 0, 0, 0);
      od = __builtin_amdgcn_mfma_f32_32x32x16_bf16(pa1, PK(l1, h1), od, 0, 0, 0); }
    { const s16x4 l2 = tr_read<v_rd_off(D0, 2, 0)>(vb), h2 = tr_read<v_rd_off(D0, 2, 1)>(vb), l3 = tr_read<v_rd_off(D0, 3, 0)>(vb), h3 = tr_read<v_rd_off(D0, 3, 1)>(vb);
      asm volatile("s_waitcnt lgkmcnt(0)" ::: "memory"); SBAR();
      od = __builtin_amdgcn_mfma_f32_32x32x16_bf16(pa2, PK(l2, h2), od, 0, 0, 0);
      od = __builtin_amdgcn_mfma_f32_32x32x16_bf16(pa3, PK(l3, h3), od, 0, 0, 0); }
#undef PK
}
template <int D0, int KS> __device__ __forceinline__ void pv_half(f32x16& od, int vb, bf16x8 paA, bf16x8 paB) {
#define PK(L, H) (bf16x8){L[0], L[1], L[2], L[3], H[0], H[1], H[2], H[3]}
    const s16x4 l0 = tr_read<v_rd_off(D0, KS, 0)>(vb), h0 = tr_read<v_rd_off(D0, KS, 1)>(vb), l1 = tr_read<v_rd_off(D0, KS + 1, 0)>(vb), h1 = tr_read<v_rd_off(D0, KS + 1, 1)>(vb);
    asm volatile("s_waitcnt lgkmcnt(0)" ::: "memory"); SBAR();
    od = __builtin_amdgcn_mfma_f32_32x32x16_bf16(paA, PK(l0, h0), od, 0, 0, 0);
    od = __builtin_amdgcn_mfma_f32_32x32x16_bf16(paB, PK(l1, h1), od, 0, 0, 0); SBAR();
#undef PK
}
__device__ __forceinline__ void qkt(f32x16& p0, f32x16& p1, const LAS char* Ks, const bf16x8* qr, int r32, int hi) {
    p0 = f32x16{}; p1 = f32x16{};
#pragma unroll
    for (int d0 = 0; d0 < 8; ++d0) { const int cb = (d0 * 16 + hi * 8) * 2;
        const bf16x8 b0 = *(const LAS bf16x8*)(Ks + KSWZ(r32, cb));
        const bf16x8 b1 = *(const LAS bf16x8*)(Ks + KSWZ(32 + r32, cb));
        p0 = __builtin_amdgcn_mfma_f32_32x32x16_bf16(b0, qr[d0], p0, 0, 0, 0);
        p1 = __builtin_amdgcn_mfma_f32_32x32x16_bf16(b1, qr[d0], p1, 0, 0, 0); }
}
#define PK4BF(P, BASE, OUT) do { unsigned a0 = cvt_pk_bf16(P[BASE + 0], P[BASE + 1]), a1 = cvt_pk_bf16(P[BASE + 2], P[BASE + 3]);   \
    unsigned b0 = cvt_pk_bf16(P[BASE + 4], P[BASE + 5]), b1 = cvt_pk_bf16(P[BASE + 6], P[BASE + 7]);                              \
    auto r0 = __builtin_amdgcn_permlane32_swap(a0, b0, false, false); auto r1 = __builtin_amdgcn_permlane32_swap(a1, b1, false, false); \
    u32x4 w = {r0[0], r1[0], r0[1], r1[1]}; OUT = __builtin_bit_cast(bf16x8, w); } while (0)
__device__ __forceinline__ unsigned pk_f16(float lo, float hi) { return __builtin_bit_cast(unsigned, __builtin_amdgcn_cvt_pkrtz(lo, hi)); }
#define PK4H(P, BASE, OUT) do { unsigned a0 = pk_f16(P[BASE + 0], P[BASE + 1]), a1 = pk_f16(P[BASE + 2], P[BASE + 3]);   \
    unsigned b0 = pk_f16(P[BASE + 4], P[BASE + 5]), b1 = pk_f16(P[BASE + 6], P[BASE + 7]);                              \
    auto r0 = __builtin_amdgcn_permlane32_swap(a0, b0, false, false); auto r1 = __builtin_amdgcn_permlane32_swap(a1, b1, false, false); \
    u32x4 w = {r0[0], r1[0], r0[1], r1[1]}; OUT = __builtin_bit_cast(f16x8, w); } while (0)
__device__ __forceinline__ float xhalf_sum(float v) { auto rr = __builtin_amdgcn_permlane32_swap(__float_as_uint(v), __float_as_uint(v), false, false); return __uint_as_float(rr[0]) + __uint_as_float(rr[1]); }
__device__ __forceinline__ float xhalf_max(float v) { auto rr = __builtin_amdgcn_permlane32_swap(__float_as_uint(v), __float_as_uint(v), false, false); return fmaxf(__uint_as_float(rr[0]), __uint_as_float(rr[1])); }

struct AttnArgs { const bf16_t* QKV; bf16_t* O; int ldo; };
template <int MODE>
__device__ __forceinline__ void attn_unit(const AttnArgs& A, int b, int qb, int qc, int kc, int vc, int oc, float slope2, int dmax, LAS char* lds) {
    const int tid = threadIdx.x, lane = tid & 63, r32 = lane & 31, hi = lane >> 5; const int wid = __builtin_amdgcn_readfirstlane(tid >> 6);
    const size_t rowb = (size_t)b * S; const int q0 = qb * 256, r0 = q0 + wid * 32;
    const bf16_t* Kg = A.QKV + rowb * LDQ + kc; const bf16_t* Vg = A.QKV + rowb * LDQ + vc;
    LAS float* ws = (LAS float*)(lds + L_WS) + wid * 64; LAS unsigned* flags = (LAS unsigned*)(lds + L_FLAG);
    bf16x8 qr[8];
    { const bf16_t* Qw = A.QKV + (rowb + r0 + r32) * LDQ + qc + hi * 8;
#pragma unroll
      for (int d0 = 0; d0 < 8; ++d0) qr[d0] = *(const bf16x8*)(Qw + d0 * 16); }
    f32x16 o[4]; o[0] = f32x16{}; o[1] = f32x16{}; o[2] = f32x16{}; o[3] = f32x16{};
    const int vb0 = (int)(uintptr_t)(lds + L_V) + v_rd_base(lane);
    const int tq = r0 + r32;
    unsigned koff[2], voff[2];
#pragma unroll
    for (int i = 0; i < 2; ++i) { const int row = 4 * wid + (lane >> 4) + 32 * i, cb = ((lane & 15) * 16) ^ ((row & 7) << 4); koff[i] = (unsigned)(row * LDQ + cb / 2);
        const int st = 2 * wid + 16 * i + (lane >> 5), kk = 8 * (st >> 2) + ((lane & 31) >> 2), key = (kk & ~0xC) | ((kk & 4) << 1) | ((kk & 8) >> 1), col = 32 * (st & 3) + (lane & 3) * 8; voff[i] = (unsigned)(key * LDQ + col); }
#define DMA_TILE(k0, bf) do { _Pragma("unroll") for (int _i = 0; _i < 2; ++_i) { \
        __builtin_amdgcn_global_load_lds((const unsigned*)(Kg + (size_t)(k0) * LDQ + koff[_i]), (LAS unsigned*)(lds + L_K + (bf) * SHM_T + wid * 1024 + _i * 8192), 16, 0, 0); \
        __builtin_amdgcn_global_load_lds((const unsigned*)(Vg + (size_t)(k0) * LDQ + voff[_i]), (LAS unsigned*)(lds + L_V + (bf) * SHM_T + wid * 1024 + _i * 8192), 16, 0, 0); } } while (0)
    const int NT = 4 * (qb + 1);
    int kt_lo = 0; if (MODE == 1) { const int lim = q0 - 63 - dmax; kt_lo = lim > 0 ? (lim + 63) / 64 : 0; }
    const int NIT = NT - kt_lo;
    if (tid < 16) flags[tid] = 0u;
    DMA_TILE((NT - 1) * KVBLK, 0);
    float carry = 0.f, m_run = -1e30f, l_run = 0.f; bool wdone = false;
    f16x8 tri0, tri1, ones;
#pragma unroll
    for (int i = 0; i < 8; ++i) { tri0[i] = (8 * hi + i > r32) ? (_Float16)1.0f : (_Float16)0.0f; tri1[i] = (16 + 8 * hi + i > r32) ? (_Float16)1.0f : (_Float16)0.0f; ones[i] = (_Float16)1.0f; }
    for (int it = 0; it < NIT; ++it) {
        const int k0 = (NT - 1 - it) * KVBLK, bf = it & 1;
        asm volatile("s_waitcnt vmcnt(0)" ::: "memory");
        __syncthreads();
        if (MODE == 0) { const u32x4 fa = *(const LAS u32x4*)(flags + ((it + 1) & 1) * 8), fb = *(const LAS u32x4*)(flags + ((it + 1) & 1) * 8 + 4);
            if (it > 0 && (fa.x & fa.y & fa.z & fa.w & fb.x & fb.y & fb.z & fb.w) != 0u) break; }
        if (it + 1 < NIT) DMA_TILE((NT - 2 - it) * KVBLK, bf ^ 1);
        const bool active = (k0 <= r0) && !wdone && (MODE == 0 || k0 + 63 + dmax >= r0);
        if (active) {
            f32x16 p0, p1;
            qkt(p0, p1, lds + L_K + bf * SHM_T, qr, r32, hi);
            const int vb = vb0 + bf * SHM_T;
            bf16x8 pa0, pa1, pa2, pa3;
            if (MODE == 0) {
                const bool need_mask = (k0 + 63 >= r0);
                float lsum = 0.f;
                float lk0[16], lk1[16];
#pragma unroll
                for (int r = 0; r < 16; ++r) {
                    { const float zl = p0[r] * QK_C, u = __builtin_amdgcn_exp2f(-fabsf(zl)), L = __builtin_amdgcn_logf(1.f + u), sp = fmaxf(zl, 0.f) + L;
                      const bool ok = !need_mask || (k0 + crow(r, hi) < tq); lk0[r] = ok ? -sp : 0.f; p0[r] = ok ? (zl - sp) : -INFINITY; lsum += lk0[r]; }
                    { const float zl = p1[r] * QK_C, u = __builtin_amdgcn_exp2f(-fabsf(zl)), L = __builtin_amdgcn_logf(1.f + u), sp = fmaxf(zl, 0.f) + L;
                      const bool ok = !need_mask || (k0 + 32 + crow(r, hi) < tq); lk1[r] = ok ? -sp : 0.f; p1[r] = ok ? (zl - sp) : -INFINITY; lsum += lk1[r]; }
                }
                f16x8 f0, f1, f2, f3; PK4H(lk0, 0, f0); PK4H(lk0, 8, f1); PK4H(lk1, 0, f2); PK4H(lk1, 8, f3);
                f32x16 w0, w1;
#pragma unroll
                for (int r = 0; r < 16; ++r) { w0[r] = carry; w1[r] = carry; }
                w0 = __builtin_amdgcn_mfma_f32_32x32x16_f16(tri0, f0, w0, 0, 0, 0); w0 = __builtin_amdgcn_mfma_f32_32x32x16_f16(tri1, f1, w0, 0, 0, 0);
                w0 = __builtin_amdgcn_mfma_f32_32x32x16_f16(ones, f2, w0, 0, 0, 0); w0 = __builtin_amdgcn_mfma_f32_32x32x16_f16(ones, f3, w0, 0, 0, 0);
                w1 = __builtin_amdgcn_mfma_f32_32x32x16_f16(tri0, f2, w1, 0, 0, 0); w1 = __builtin_amdgcn_mfma_f32_32x32x16_f16(tri1, f3, w1, 0, 0, 0);
#pragma unroll
                for (int r = 0; r < 16; ++r) { p0[r] = __builtin_amdgcn_exp2f(p0[r] + w0[r]); p1[r] = __builtin_amdgcn_exp2f(p1[r] + w1[r]); }
                carry += xhalf_sum(lsum);
                wdone = __all(carry < -150.f);
            } else {
                const bool need_mask = (k0 + 63 > r0);
                const float fb = (float)(k0 - tq + 4 * hi);
                float mx = -1e30f;
#pragma unroll
                for (int r = 0; r < 16; ++r) { const float t0 = fb + (float)((r & 3) + 8 * (r >> 2)), t1 = t0 + 32.f;
                    float z0 = fmaf(slope2, t0, p0[r] * QK_C), z1 = fmaf(slope2, t1, p1[r] * QK_C);
                    if (need_mask) { if (t0 > 0.f) z0 = -INFINITY; if (t1 > 0.f) z1 = -INFINITY; }
                    p0[r] = z0; p1[r] = z1; mx = fmaxf(mx, fmaxf(z0, z1)); }
                mx = xhalf_max(mx);
                const float mn = fmaxf(m_run, mx), alpha = __builtin_amdgcn_exp2f(m_run - mn); m_run = mn;
                float ps = 0.f;
#pragma unroll
                for (int r = 0; r < 16; ++r) { p0[r] = __builtin_amdgcn_exp2f(p0[r] - mn); p1[r] = __builtin_amdgcn_exp2f(p1[r] - mn); ps += p0[r] + p1[r]; }
                l_run = l_run * alpha + xhalf_sum(ps);
                if (__any(alpha < 1.f)) { if (hi == 0) ws[r32] = alpha; asm volatile("s_waitcnt lgkmcnt(0)" ::: "memory");
#pragma unroll
                    for (int r = 0; r < 16; ++r) { const float a_ = ws[crow(r, hi)];
#pragma unroll
                        for (int d = 0; d < 4; ++d) o[d][r] *= a_; } }
            }
            PK4BF(p0, 0, pa0); PK4BF(p0, 8, pa1); PK4BF(p1, 0, pa2); PK4BF(p1, 8, pa3);
            SBAR();
            {
              s16x4 aL0, aH0, aL1, aH1, bL0, bH0, bL1, bH1;
#define PVRD(S, D0, KS) do { S##L0 = tr_read<v_rd_off(D0, KS, 0)>(vb); S##H0 = tr_read<v_rd_off(D0, KS, 1)>(vb); S##L1 = tr_read<v_rd_off(D0, KS + 1, 0)>(vb); S##H1 = tr_read<v_rd_off(D0, KS + 1, 1)>(vb); } while (0)
#define PVMM(S, OD, PA, PB, WAITN) do { asm volatile("s_waitcnt lgkmcnt(" #WAITN ")" ::: "memory"); SBAR(); \
        OD = __builtin_amdgcn_mfma_f32_32x32x16_bf16(PA, ((bf16x8){S##L0[0], S##L0[1], S##L0[2], S##L0[3], S##H0[0], S##H0[1], S##H0[2], S##H0[3]}), OD, 0, 0, 0); \
        OD = __builtin_amdgcn_mfma_f32_32x32x16_bf16(PB, ((bf16x8){S##L1[0], S##L1[1], S##L1[2], S##L1[3], S##H1[0], S##H1[1], S##H1[2], S##H1[3]}), OD, 0, 0, 0); SBAR(); } while (0)
              PVRD(a, 0, 0);
              PVRD(b, 1, 0); PVMM(a, o[0], pa0, pa1, 4); PVRD(a, 2, 0); PVMM(b, o[1], pa0, pa1, 4);
              PVRD(b, 3, 0); PVMM(a, o[2], pa0, pa1, 4); PVRD(a, 0, 2); PVMM(b, o[3], pa0, pa1, 4);
              PVRD(b, 1, 2); PVMM(a, o[0], pa2, pa3, 4); PVRD(a, 2, 2); PVMM(b, o[1], pa2, pa3, 4);
              PVRD(b, 3, 2); PVMM(a, o[2], pa2, pa3, 4);                PVMM(b, o[3], pa2, pa3, 0);
#undef PVRD
#undef PVMM
            }
        }
        if (MODE == 0 && lane == 0) flags[bf * 8 + wid] = wdone ? 1u : 0u;
    }
    __syncthreads();
    float rli[16];
    if (MODE == 1) { if (hi == 0) ws[32 + r32] = l_run; asm volatile("s_waitcnt lgkmcnt(0)" ::: "memory");
#pragma unroll
        for (int r = 0; r < 16; ++r) rli[r] = __builtin_amdgcn_rcpf(ws[32 + crow(r, hi)]); }
    else {
#pragma unroll
        for (int r = 0; r < 16; ++r) rli[r] = 1.f; }
#if DENSE0_OUT8
    if (MODE == 0) {
        LAS unsigned char* stg8 = (LAS unsigned char*)(lds + wid * 8192);
#pragma unroll
        for (int r = 0; r < 16; ++r) { const int orow = crow(r, hi);
#pragma unroll
            for (int d0 = 0; d0 < 4; ++d0) stg8[orow * 128 + d0 * 32 + r32] = (unsigned char)(pk4_fp8(o[d0][r] * O_SC, 0.f, 0.f, 0.f) & 0xffu); }
        asm volatile("s_waitcnt lgkmcnt(0)" ::: "memory");
        unsigned char* Ow8 = (unsigned char*)A.O + (rowb + r0) * (size_t)A.ldo + oc;
#pragma unroll
        for (int i = 0; i < 4; ++i) { const int row = i * 8 + (lane >> 3), ch = lane & 7; const u32x4 v = *(const LAS u32x4*)(stg8 + row * 128 + ch * 16); *(u32x4*)(Ow8 + (size_t)row * A.ldo + ch * 16) = v; }
    } else
#endif
    {
    LAS bf16_t* stg = (LAS bf16_t*)(lds + wid * 8192);
#pragma unroll
    for (int r = 0; r < 16; ++r) { const int orow = crow(r, hi);
#pragma unroll
        for (int d0 = 0; d0 < 4; ++d0) stg[orow * 128 + d0 * 32 + r32] = (bf16_t)(cvt_pk_bf16(o[d0][r] * rli[r], 0.f) & 0xffffu); }
    asm volatile("s_waitcnt lgkmcnt(0)" ::: "memory");
    bf16_t* Ow = A.O + (rowb + r0) * (size_t)A.ldo + oc;
#pragma unroll
    for (int i = 0; i < 8; ++i) { const int row = i * 4 + (lane >> 4), ch = lane & 15; const u32x4 v = *(const LAS u32x4*)(stg + row * 128 + ch * 8); *(u32x4*)(Ow + (size_t)row * A.ldo + ch * 8) = v; }
    }
    __syncthreads();
#undef DMA_TILE
}

__device__ __forceinline__ void attn_unit_da(const bf16_t* QKV, bf16_t* O, int b, int h, int qb, float slope2, int dmax, bool freeze_ok, const float* const* in, float lambda_init, LAS char* lds) {
    const int tid = threadIdx.x, lane = tid & 63, r32 = lane & 31, hi = lane >> 5; const int wid = __builtin_amdgcn_readfirstlane(tid >> 6);
    const int rg = wid & 3, c = wid >> 2;
    const size_t rowb = (size_t)b * S; const int q0 = qb * 128, r0 = q0 + rg * 32;
    const bf16_t* Kg0 = QKV + rowb * LDQ + D + h * 256; const bf16_t* Vg = QKV + rowb * LDQ + 2 * D + h * 256;
    constexpr int STG = 4 * SHM_T;
    LAS float* ws = (LAS float*)(lds + 2 * STG) + wid * 64;
    bf16x8 qr[8];
    { const bf16_t* Qw = QKV + (rowb + r0 + r32) * LDQ + h * 256 + c * 128 + hi * 8;
#pragma unroll
      for (int d0 = 0; d0 < 8; ++d0) { const u32x4 w = *(const u32x4*)(Qw + d0 * 16);
          u32x4 o_; o_.x = cvt_pk_bf16(bf_lo(w.x) * QK_C, bf_hi(w.x) * QK_C); o_.y = cvt_pk_bf16(bf_lo(w.y) * QK_C, bf_hi(w.y) * QK_C); o_.z = cvt_pk_bf16(bf_lo(w.z) * QK_C, bf_hi(w.z) * QK_C); o_.w = cvt_pk_bf16(bf_lo(w.w) * QK_C, bf_hi(w.w) * QK_C);
          qr[d0] = __builtin_bit_cast(bf16x8, o_); } }
    f32x16 o[8];
#pragma unroll
    for (int d = 0; d < 8; ++d) o[d] = f32x16{};
    const int vb0 = (int)(uintptr_t)(lds + 2 * SHM_T) + v_rd_base(lane);
#if DA_SWPIPE
#define DMA_OFFS() int ln_ = lane; asm volatile("" : "+v"(ln_)); unsigned koff[2], voff[2]; _Pragma("unroll") for (int i = 0; i < 2; ++i) { const int row = 4 * wid + (ln_ >> 4) + 32 * i, cb = ((ln_ & 15) * 16) ^ ((row & 7) << 4); koff[i] = (unsigned)(row * LDQ + cb / 2); \
        const int st = 2 * wid + 16 * i + (ln_ >> 5), kk_ = 8 * (st >> 2) + ((ln_ & 31) >> 2), key = (kk_ & ~0xC) | ((kk_ & 4) << 1) | ((kk_ & 8) >> 1), col = 32 * (st & 3) + (ln_ & 3) * 8; voff[i] = (unsigned)(key * LDQ + col); }
#define DMA_K(kk) do { DMA_OFFS(); const size_t kr_ = (size_t)((NT - 1 - (kk)) * KVBLK) * LDQ; _Pragma("unroll") for (int _i = 0; _i < 2; ++_i) { \
        __builtin_amdgcn_global_load_lds((const unsigned*)(Kg0 + kr_ + koff[_i]), (LAS unsigned*)(lds + ((kk) & 1) * STG + wid * 1024 + _i * 8192), 16, 0, 0); \
        __builtin_amdgcn_global_load_lds((const unsigned*)(Kg0 + kr_ + koff[_i] + 128), (LAS unsigned*)(lds + ((kk) & 1) * STG + SHM_T + wid * 1024 + _i * 8192), 16, 0, 0); } } while (0)
#define DMA_V(kk) do { DMA_OFFS(); const size_t kr_ = (size_t)((NT - 1 - (kk)) * KVBLK) * LDQ; _Pragma("unroll") for (int _i = 0; _i < 2; ++_i) { \
        __builtin_amdgcn_global_load_lds((const unsigned*)(Vg + kr_ + voff[_i]), (LAS unsigned*)(lds + ((kk) & 1) * STG + 2 * SHM_T + wid * 1024 + _i * 8192), 16, 0, 0); \
        __builtin_amdgcn_global_load_lds((const unsigned*)(Vg + kr_ + voff[_i] + 128), (LAS unsigned*)(lds + ((kk) & 1) * STG + 3 * SHM_T + wid * 1024 + _i * 8192), 16, 0, 0); } } while (0)
    const int NT = 2 * (qb + 1);
    int kt_lo = 0; { const int lim = q0 - 63 - dmax; kt_lo = lim > 0 ? (lim + 63) / 64 : 0; }
    const int NIT = NT - kt_lo;
    float m_run = -1e30f, l_run = 0.f;
    f32x16 p0, p1; bf16x8 pa0, pa1, pa2, pa3;
#define ACT(kk) ((kk) >= 0 && (kk) < NIT && (NT - 1 - (kk)) * KVBLK <= r0 && (NT - 1 - (kk)) * KVBLK + 63 + dmax >= r0)
#define PVRD(S, D0, KS, VBH) do { S##L0 = tr_read<v_rd_off(D0, KS, 0)>(VBH); S##H0 = tr_read<v_rd_off(D0, KS, 1)>(VBH); S##L1 = tr_read<v_rd_off(D0, KS + 1, 0)>(VBH); S##H1 = tr_read<v_rd_off(D0, KS + 1, 1)>(VBH); } while (0)
#define PVMM(S, OD, PA, PB, WAITN) do { asm volatile("s_waitcnt lgkmcnt(" #WAITN ")" ::: "memory"); SBAR(); \
        OD = __builtin_amdgcn_mfma_f32_32x32x16_bf16(PA, ((bf16x8){S##L0[0], S##L0[1], S##L0[2], S##L0[3], S##H0[0], S##H0[1], S##H0[2], S##H0[3]}), OD, 0, 0, 0); \
        OD = __builtin_amdgcn_mfma_f32_32x32x16_bf16(PB, ((bf16x8){S##L1[0], S##L1[1], S##L1[2], S##L1[3], S##H1[0], S##H1[1], S##H1[2], S##H1[3]}), OD, 0, 0, 0); SBAR(); } while (0)
#define QKRD(S, KB, OFF) do { S##0 = *(const LAS bf16x8*)((KB) + (OFF)); S##1 = *(const LAS bf16x8*)((KB) + (OFF) + 8192); } while (0)
#define QKMM(S, QI, WAITN) do { asm volatile("s_waitcnt lgkmcnt(" #WAITN ")" ::: "memory"); SBAR(); \
        p0 = __builtin_amdgcn_mfma_f32_32x32x16_bf16(S##0, qr[QI], p0, 0, 0, 0); p1 = __builtin_amdgcn_mfma_f32_32x32x16_bf16(S##1, qr[QI], p1, 0, 0, 0); SBAR(); } while (0)
#define MPART(kk) do { \
        if (ACT((kk) - 1)) { const int vb = vb0 + (((kk) - 1) & 1) * STG; s16x4 aL0, aH0, aL1, aH1, bL0, bH0, bL1, bH1; \
            PVRD(a, 0, 0, vb); \
            PVRD(b, 1, 0, vb);         PVMM(a, o[0], pa0, pa1, 4); PVRD(a, 2, 0, vb);         PVMM(b, o[1], pa0, pa1, 4); \
            PVRD(b, 3, 0, vb);         PVMM(a, o[2], pa0, pa1, 4); PVRD(a, 0, 0, vb + SHM_T); PVMM(b, o[3], pa0, pa1, 4); \
            PVRD(b, 1, 0, vb + SHM_T); PVMM(a, o[4], pa0, pa1, 4); PVRD(a, 2, 0, vb + SHM_T); PVMM(b, o[5], pa0, pa1, 4); \
            PVRD(b, 3, 0, vb + SHM_T); PVMM(a, o[6], pa0, pa1, 4); PVRD(a, 0, 2, vb);         PVMM(b, o[7], pa0, pa1, 4); \
            PVRD(b, 1, 2, vb);         PVMM(a, o[0], pa2, pa3, 4); PVRD(a, 2, 2, vb);         PVMM(b, o[1], pa2, pa3, 4); \
            PVRD(b, 3, 2, vb);         PVMM(a, o[2], pa2, pa3, 4); PVRD(a, 0, 2, vb + SHM_T); PVMM(b, o[3], pa2, pa3, 4); \
            PVRD(b, 1, 2, vb + SHM_T); PVMM(a, o[4], pa2, pa3, 4); PVRD(a, 2, 2, vb + SHM_T); PVMM(b, o[5], pa2, pa3, 4); \
            PVRD(b, 3, 2, vb + SHM_T); PVMM(a, o[6], pa2, pa3, 4); PVMM(b, o[7], pa2, pa3, 0); } \
        if (ACT(kk)) { const int k0 = (NT - 1 - (kk)) * KVBLK; int lt_ = lane; asm volatile("" : "+v"(lt_)); const int hi_t = lt_ >> 5, r32_t = lt_ & 31; \
            const float cb = slope2 * (float)(k0 - r0 + 4 * hi_t); float sl_ = slope2; asm volatile("" : "+v"(sl_)); \
            _Pragma("unroll") for (int r = 0; r < 16; ++r) { p0[r] = fmaf(sl_, (float)((r & 3) + 8 * (r >> 2)), cb); p1[r] = fmaf(sl_, (float)(32 + (r & 3) + 8 * (r >> 2)), cb); } \
            const LAS char* Ks = lds + ((kk) & 1) * STG + c * SHM_T; \
            const LAS char* kb0 = Ks + (r32_t * 256 + (((0 * 2 + hi_t) ^ (r32_t & 7)) << 4)); const LAS char* kb1 = Ks + (r32_t * 256 + (((1 * 2 + hi_t) ^ (r32_t & 7)) << 4)); \
            const LAS char* kb2 = Ks + (r32_t * 256 + (((2 * 2 + hi_t) ^ (r32_t & 7)) << 4)); const LAS char* kb3 = Ks + (r32_t * 256 + (((3 * 2 + hi_t) ^ (r32_t & 7)) << 4)); \
            bf16x8 xa0, xa1, xb0, xb1; \
            QKRD(xa, kb0, 0); QKRD(xb, kb0, 128); QKMM(xa, 0, 2); QKRD(xa, kb1, 0); QKMM(xb, 4, 2); QKRD(xb, kb1, 128); QKMM(xa, 1, 2); QKRD(xa, kb2, 0); QKMM(xb, 5, 2); \
            QKRD(xb, kb2, 128); QKMM(xa, 2, 2); QKRD(xa, kb3, 0); QKMM(xb, 6, 2); QKRD(xb, kb3, 128); QKMM(xa, 3, 2); QKMM(xb, 7, 0); } } while (0)
#define VPART(kk) do { if (ACT(kk)) { const int k0 = (NT - 1 - (kk)) * KVBLK; int lt_ = lane; asm volatile("" : "+v"(lt_)); const int hi_t = lt_ >> 5, r32_t = lt_ & 31; \
            float mx = -1e30f; \
            if (k0 + 63 > r0) { const int kq = k0 - (r0 + r32_t) + 4 * hi_t; \
                _Pragma("unroll") for (int r = 0; r < 16; ++r) { const int kr = kq + (r & 3) + 8 * (r >> 2); if (kr > 0) p0[r] = -INFINITY; if (kr + 32 > 0) p1[r] = -INFINITY; } } \
            _Pragma("unroll") for (int r = 0; r < 16; ++r) mx = fmaxf(mx, fmaxf(p0[r], p1[r])); \
            mx = xhalf_max(mx); \
            const float mn = fmaxf(m_run, mx), alpha = __builtin_amdgcn_exp2f(m_run - mn); m_run = mn; \
            float ps = 0.f; \
            _Pragma("unroll") for (int r = 0; r < 16; ++r) { p0[r] = __builtin_amdgcn_exp2f(p0[r] - mn); p1[r] = __builtin_amdgcn_exp2f(p1[r] - mn); ps += p0[r] + p1[r]; } \
            l_run = l_run * alpha + xhalf_sum(ps); \
            if (__any(alpha < 1.f)) { LAS float* ws_t = (LAS float*)(lds + 2 * STG) + wid * 64; if (hi_t == 0) ws_t[r32_t] = alpha; asm volatile("s_waitcnt lgkmcnt(0)" ::: "memory"); const LAS float* wa_t = ws_t + 4 * hi_t; \
                _Pragma("unroll") for (int r = 0; r < 16; ++r) { const float a_ = wa_t[(r & 3) + 8 * (r >> 2)]; _Pragma("unroll") for (int d = 0; d < 8; ++d) o[d][r] *= a_; } } \
            PK4BF(p0, 0, pa0); PK4BF(p0, 8, pa1); PK4BF(p1, 0, pa2); PK4BF(p1, 8, pa3); } } while (0)
#define SLOT_BAR() do { asm volatile("s_waitcnt vmcnt(0)" ::: "memory"); __syncthreads(); } while (0)
#define DMA_STEP(kk) do { if ((kk) + 1 < NIT) DMA_K((kk) + 1); if ((kk) >= 1 && (kk) < NIT) DMA_V(kk); } while (0)
    DMA_K(0); DMA_V(0);
    if (c == 1) { SLOT_BAR(); DMA_STEP(0); }
    for (int k = 0; k <= NIT; ++k) {
        SLOT_BAR(); if (c == 0) DMA_STEP(k);
        MPART(k);
        SLOT_BAR(); if (c == 1) DMA_STEP(k + 1);
        VPART(k);
    }
    if (c == 0) SLOT_BAR();
#undef DMA_STEP
#undef DMA_OFFS
#undef DMA_K
#undef DMA_V
#undef ACT
#undef PVRD
#undef PVMM
#undef QKRD
#undef QKMM
#undef MPART
#undef VPART
#undef SLOT_BAR
#else
#define DMA_DA(k0, bf) do { int ln_ = lane; asm volatile("" : "+v"(ln_)); unsigned koff[2], voff[2]; _Pragma("unroll") for (int i = 0; i < 2; ++i) { const int row = 4 * wid + (ln_ >> 4) + 32 * i, cb = ((ln_ & 15) * 16) ^ ((row & 7) << 4); koff[i] = (unsigned)(row * LDQ + cb / 2); \
        const int st = 2 * wid + 16 * i + (ln_ >> 5), kk = 8 * (st >> 2) + ((ln_ & 31) >> 2), key = (kk & ~0xC) | ((kk & 4) << 1) | ((kk & 8) >> 1), col = 32 * (st & 3) + (ln_ & 3) * 8; voff[i] = (unsigned)(key * LDQ + col); } \
    _Pragma("unroll") for (int _i = 0; _i < 2; ++_i) { \
        __builtin_amdgcn_global_load_lds((const unsigned*)(Kg0 + (size_t)(k0) * LDQ + koff[_i]), (LAS unsigned*)(lds + (bf) * STG + wid * 1024 + _i * 8192), 16, 0, 0); \
        __builtin_amdgcn_global_load_lds((const unsigned*)(Kg0 + (size_t)(k0) * LDQ + koff[_i] + 128), (LAS unsigned*)(lds + (bf) * STG + SHM_T + wid * 1024 + _i * 8192), 16, 0, 0); \
        __builtin_amdgcn_global_load_lds((const unsigned*)(Vg + (size_t)(k0) * LDQ + voff[_i]), (LAS unsigned*)(lds + (bf) * STG + 2 * SHM_T + wid * 1024 + _i * 8192), 16, 0, 0); \
        __builtin_amdgcn_global_load_lds((const unsigned*)(Vg + (size_t)(k0) * LDQ + voff[_i] + 128), (LAS unsigned*)(lds + (bf) * STG + 3 * SHM_T + wid * 1024 + _i * 8192), 16, 0, 0); } } while (0)
    const int NT = 2 * (qb + 1);
    int kt_lo = 0; { const int lim = q0 - 63 - dmax; kt_lo = lim > 0 ? (lim + 63) / 64 : 0; }
    const int NIT = NT - kt_lo;
    DMA_DA((NT - 1) * KVBLK, 0);
    float m_run = -1e30f, l_run = 0.f;
    for (int it = 0; it < NIT; ++it) {
        const int k0 = (NT - 1 - it) * KVBLK, bf = it & 1;
        asm volatile("s_waitcnt vmcnt(0)" ::: "memory");
        __syncthreads();
        if (it + 1 < NIT) DMA_DA((NT - 2 - it) * KVBLK, bf ^ 1);
        const bool active = (k0 <= r0) && (k0 + 63 + dmax >= r0);
        if (active) {
            int lt_ = lane; asm volatile("" : "+v"(lt_)); const int hi_t = lt_ >> 5, r32_t = lt_ & 31;
            const float fb = slope2 * (float)(k0 - r0 + 4 * hi_t);
            const bool need_mask = (k0 + 63 > r0);
            const float cb = fb;
            f32x16 p0, p1; float sl_ = slope2; asm volatile("" : "+v"(sl_));
#pragma unroll
            for (int r = 0; r < 16; ++r) { p0[r] = fmaf(sl_, (float)((r & 3) + 8 * (r >> 2)), cb); p1[r] = fmaf(sl_, (float)(32 + (r & 3) + 8 * (r >> 2)), cb); }
            {
              const LAS char* Ks = lds + bf * STG + c * SHM_T; int ln_ = lane; asm volatile("" : "+v"(ln_)); const int r32_ = ln_ & 31, hi_ = ln_ >> 5;
              const LAS char* kb0 = Ks + (r32_ * 256 + (((0 * 2 + hi_) ^ (r32_ & 7)) << 4)); const LAS char* kb1 = Ks + (r32_ * 256 + (((1 * 2 + hi_) ^ (r32_ & 7)) << 4));
              const LAS char* kb2 = Ks + (r32_ * 256 + (((2 * 2 + hi_) ^ (r32_ & 7)) << 4)); const LAS char* kb3 = Ks + (r32_ * 256 + (((3 * 2 + hi_) ^ (r32_ & 7)) << 4));
              bf16x8 xa0, xa1, xb0, xb1;
#define QKRD(S, KB, OFF) do { S##0 = *(const LAS bf16x8*)((KB) + (OFF)); S##1 = *(const LAS bf16x8*)((KB) + (OFF) + 8192); } while (0)
#define QKMM(S, QI, WAITN) do { asm volatile("s_waitcnt lgkmcnt(" #WAITN ")" ::: "memory"); SBAR(); \
        p0 = __builtin_amdgcn_mfma_f32_32x32x16_bf16(S##0, qr[QI], p0, 0, 0, 0); p1 = __builtin_amdgcn_mfma_f32_32x32x16_bf16(S##1, qr[QI], p1, 0, 0, 0); SBAR(); } while (0)
              QKRD(xa, kb0, 0);
              QKRD(xb, kb0, 128); QKMM(xa, 0, 2);
              QKRD(xa, kb1, 0);   QKMM(xb, 4, 2);
              QKRD(xb, kb1, 128); QKMM(xa, 1, 2);
              QKRD(xa, kb2, 0);   QKMM(xb, 5, 2);
              QKRD(xb, kb2, 128); QKMM(xa, 2, 2);
              QKRD(xa, kb3, 0);   QKMM(xb, 6, 2);
              QKRD(xb, kb3, 128); QKMM(xa, 3, 2);
                                  QKMM(xb, 7, 0);
#undef QKRD
#undef QKMM
            }
            {
                float mx = -1e30f;
                if (need_mask) { const int kq = k0 - (r0 + r32_t) + 4 * hi_t;
#pragma unroll
                    for (int r = 0; r < 16; ++r) { const int kr = kq + (r & 3) + 8 * (r >> 2); if (kr > 0) p0[r] = -INFINITY; if (kr + 32 > 0) p1[r] = -INFINITY; } }
#pragma unroll
                for (int r = 0; r < 16; ++r) mx = fmaxf(mx, fmaxf(p0[r], p1[r]));
                mx = xhalf_max(mx);
                const float mn = fmaxf(m_run, mx), alpha = __builtin_amdgcn_exp2f(m_run - mn); m_run = mn;
                float ps = 0.f;
#pragma unroll
                for (int r = 0; r < 16; ++r) { p0[r] = __builtin_amdgcn_exp2f(p0[r] - mn); p1[r] = __builtin_amdgcn_exp2f(p1[r] - mn); ps += p0[r] + p1[r]; }
                l_run = l_run * alpha + xhalf_sum(ps);
                if (__any(alpha < 1.f)) { LAS float* ws_t = (LAS float*)(lds + 2 * STG) + wid * 64; if (hi_t == 0) ws_t[r32_t] = alpha; asm volatile("s_waitcnt lgkmcnt(0)" ::: "memory"); const LAS float* wa_t = ws_t + 4 * hi_t;
#pragma unroll
                    for (int r = 0; r < 16; ++r) { const float a_ = wa_t[(r & 3) + 8 * (r >> 2)];
#pragma unroll
                        for (int d = 0; d < 8; ++d) o[d][r] *= a_; } }
            }
            const int vb = vb0 + bf * STG;
            bf16x8 pa0, pa1, pa2, pa3; PK4BF(p0, 0, pa0); PK4BF(p0, 8, pa1); PK4BF(p1, 0, pa2); PK4BF(p1, 8, pa3); SBAR();
            s16x4 aL0, aH0, aL1, aH1, bL0, bH0, bL1, bH1;
#define PVRD(S, D0, KS, VBH) do { S##L0 = tr_read<v_rd_off(D0, KS, 0)>(VBH); S##H0 = tr_read<v_rd_off(D0, KS, 1)>(VBH); S##L1 = tr_read<v_rd_off(D0, KS + 1, 0)>(VBH); S##H1 = tr_read<v_rd_off(D0, KS + 1, 1)>(VBH); } while (0)
#define PVMM(S, OD, PA, PB, WAITN) do { asm volatile("s_waitcnt lgkmcnt(" #WAITN ")" ::: "memory"); SBAR(); \
        OD = __builtin_amdgcn_mfma_f32_32x32x16_bf16(PA, ((bf16x8){S##L0[0], S##L0[1], S##L0[2], S##L0[3], S##H0[0], S##H0[1], S##H0[2], S##H0[3]}), OD, 0, 0, 0); \
        OD = __builtin_amdgcn_mfma_f32_32x32x16_bf16(PB, ((bf16x8){S##L1[0], S##L1[1], S##L1[2], S##L1[3], S##H1[0], S##H1[1], S##H1[2], S##H1[3]}), OD, 0, 0, 0); SBAR(); } while (0)
            PVRD(a, 0, 0, vb);
            PVRD(b, 1, 0, vb);         PVMM(a, o[0], pa0, pa1, 4);
            PVRD(a, 2, 0, vb);         PVMM(b, o[1], pa0, pa1, 4);
            PVRD(b, 3, 0, vb);         PVMM(a, o[2], pa0, pa1, 4);
            PVRD(a, 0, 0, vb + SHM_T); PVMM(b, o[3], pa0, pa1, 4);
            PVRD(b, 1, 0, vb + SHM_T); PVMM(a, o[4], pa0, pa1, 4);
            PVRD(a, 2, 0, vb + SHM_T); PVMM(b, o[5], pa0, pa1, 4);
            PVRD(b, 3, 0, vb + SHM_T); PVMM(a, o[6], pa0, pa1, 4);
            PVRD(a, 0, 2, vb);         PVMM(b, o[7], pa0, pa1, 4);
            PVRD(b, 1, 2, vb);         PVMM(a, o[0], pa2, pa3, 4);
            PVRD(a, 2, 2, vb);         PVMM(b, o[1], pa2, pa3, 4);
            PVRD(b, 3, 2, vb);         PVMM(a, o[2], pa2, pa3, 4);
            PVRD(a, 0, 2, vb + SHM_T); PVMM(b, o[3], pa2, pa3, 4);
            PVRD(b, 1, 2, vb + SHM_T); PVMM(a, o[4], pa2, pa3, 4);
            PVRD(a, 2, 2, vb + SHM_T); PVMM(b, o[5], pa2, pa3, 4);
            PVRD(b, 3, 2, vb + SHM_T); PVMM(a, o[6], pa2, pa3, 4);
                                       PVMM(b, o[7], pa2, pa3, 0);
#undef PVRD
#undef PVMM
        }
    }
#endif
    __syncthreads();
    int hi_e = hi, r32_e = r32, lane_e = lane; asm volatile("" : "+v"(hi_e), "+v"(r32_e), "+v"(lane_e));
    { if (hi_e == 0) ws[32 + r32_e] = l_run; asm volatile("s_waitcnt lgkmcnt(0)" ::: "memory");
      const LAS float* wl = ws + 32 + 4 * hi_e;
#pragma unroll
      for (int r = 0; r < 16; ++r) { const float rl = __builtin_amdgcn_rcpf(wl[(r & 3) + 8 * (r >> 2)]);
#pragma unroll
          for (int d = 0; d < 8; ++d) o[d][r] *= rl; } }
    LAS float* slab = (LAS float*)(lds + rg * 32768) + lane_e;
    if (c == 1) {
#pragma unroll
        for (int d = 0; d < 8; ++d)
#pragma unroll
            for (int r = 0; r < 16; ++r) slab[(d * 16 + r) * 64] = o[d][r];
    }
    __syncthreads();
    if (c == 0) {
        float s1 = in[10][lane_e] * in[11][lane_e] + in[10][lane_e + 64] * in[11][lane_e + 64], s2 = in[12][lane_e] * in[13][lane_e] + in[12][lane_e + 64] * in[13][lane_e + 64];
        s1 = wave_sum(s1); s2 = wave_sum(s2);
        const float lam = __expf(s1) - __expf(s2) + lambda_init, out_scale = 1.f - lambda_init; const float* subln = in[14];
        float ssq[16];
#pragma unroll
        for (int r = 0; r < 16; ++r) ssq[r] = 0.f;
#pragma unroll
        for (int d = 0; d < 8; ++d)
#pragma unroll
            for (int r = 0; r < 16; ++r) { const float v = o[d][r] - lam * slab[(d * 16 + r) * 64]; o[d][r] = v; ssq[r] += v * v; }
#pragma unroll
        for (int r = 0; r < 16; ++r) { float s_ = ssq[r]; s_ += __shfl_xor(s_, 1); s_ += __shfl_xor(s_, 2); s_ += __shfl_xor(s_, 4); s_ += __shfl_xor(s_, 8); s_ += __shfl_xor(s_, 16);
            ssq[r] = rsqrtf(s_ * (1.f / 256.f) + SUBLN_EPS) * out_scale; }
        asm volatile("s_waitcnt lgkmcnt(0)" ::: "memory");
#if DENSE1_FP8
        LAS unsigned char* stg = (LAS unsigned char*)(lds + rg * 32768);
        LAS unsigned char* stw = stg + hi_e * 1024 + r32_e;
#pragma unroll
        for (int d = 0; d < 8; ++d) { const float g = subln[d * 32 + r32_e] * O_SC;
#pragma unroll
            for (int r = 0; r < 16; ++r) stw[((r & 3) + 8 * (r >> 2)) * 256 + d * 32] = (unsigned char)(pk4_fp8(o[d][r] * ssq[r] * g, 0.f, 0.f, 0.f) & 0xffu); }
        asm volatile("s_waitcnt lgkmcnt(0)" ::: "memory");
        unsigned char* Ow = (unsigned char*)O + (rowb + r0 + (lane_e >> 4)) * (size_t)D + h * 256 + (lane_e & 15) * 16;
        const LAS unsigned char* str_ = stg + (lane_e >> 4) * 256 + (lane_e & 15) * 16;
#pragma unroll
        for (int i = 0; i < 8; ++i) { const u32x4 v = *(const LAS u32x4*)(str_ + i * 1024); *(u32x4*)(Ow + (size_t)i * 4 * D) = v; }
#else
        LAS bf16_t* stg = (LAS bf16_t*)(lds + rg * 32768);
        LAS bf16_t* stw = stg + hi_e * 1024 + r32_e;
#pragma unroll
        for (int d = 0; d < 8; ++d) { const float g = subln[d * 32 + r32_e];
#pragma unroll
            for (int r = 0; r < 16; ++r) stw[((r & 3) + 8 * (r >> 2)) * 256 + d * 32] = (bf16_t)(cvt_pk_bf16(o[d][r] * ssq[r] * g, 0.f) & 0xffffu); }
        asm volatile("s_waitcnt lgkmcnt(0)" ::: "memory");
        bf16_t* Ow = O + (rowb + r0 + (lane_e >> 5)) * (size_t)D + h * 256 + (lane_e & 31) * 8;
        const LAS bf16_t* str_ = stg + (lane_e >> 5) * 256 + (lane_e & 31) * 8;
#pragma unroll
        for (int i = 0; i < 16; ++i) { const u32x4 v = *(const LAS u32x4*)(str_ + i * 512); *(u32x4*)(Ow + (size_t)i * 2 * D) = v; }
#endif
    }
    __syncthreads();
#if !DA_SWPIPE
#undef DMA_DA
#endif
}
}
constexpr int NWAVES = 8, NTHREADS = 512;
constexpr size_t MiB = 1u << 20;
constexpr int RING_BYTES = 133120;
constexpr int TAB_OFF = RING_BYTES;
constexpr int TAB_IDX = TAB_OFF, TAB_TILE = TAB_OFF + 2048, TAB_MISC = TAB_TILE + 2048, TAB_END = TAB_MISC + 1024;
constexpr int MISC_OFF = TAB_END;
constexpr int EPI_OFF = 139264;
constexpr int LDS_BYTES = 147456;
static_assert(MISC_OFF + 128 <= EPI_OFF && EPI_OFF + 8192 <= LDS_BYTES, "LDS map");
constexpr size_t WS_CTL = 0, CTL_ZERO_BYTES = 1 * MiB;
constexpr size_t WS_TOK = WS_CTL + CTL_ZERO_BYTES;
constexpr size_t ZERO_BYTES = CTL_ZERO_BYTES + (size_t)NS * 4;
constexpr size_t WS_MOD = 2 * MiB;
constexpr size_t WS_LOGIT = 340 * MiB;
constexpr size_t WS_TOPE = 7 * MiB, WS_GATE = 8 * MiB, WS_LPOS = 9 * MiB, WS_SLOT = 10 * MiB;
constexpr size_t WS_CNT = 11 * MiB;
constexpr size_t WS_TILEE = 11 * MiB + 128 * 1024;
constexpr size_t WS_WIN = 12 * MiB;
constexpr size_t WS_WOUT = 60 * MiB;
constexpr size_t WS_WR = 76 * MiB;
#ifndef MOE_FP8
#define MOE_FP8 1
#endif
constexpr float W1_SC = 64.f, W2_SC = 32.f, ACT_SC = 4.f, Y_SC = 8.f;
constexpr size_t WS_WIN8 = 12 * MiB + 24 * MiB, WS_WOUT8 = 60 * MiB + 8 * MiB;
constexpr size_t WS_W1 = 78 * MiB;
constexpr size_t WS_W2 = 598 * MiB;
constexpr size_t WS_XN8 = 730 * MiB;
constexpr size_t WS_XA = 858 * MiB;
constexpr size_t WS_XB = 922 * MiB;
constexpr size_t WS_XN = 986 * MiB;
constexpr size_t WS_ACT = 1050 * MiB;
constexpr size_t WS_R = 1178 * MiB;
constexpr size_t WS_QKV = WS_R, WS_O = WS_R + 192 * MiB, WS_OT = WS_R + 256 * MiB, WS_Y = WS_R;
constexpr size_t WS_END = WS_R + 512 * MiB;
constexpr int CW_TMO = 0, CW_BAR = 4096;

#define XB_TMO      128
#define XB_XCNT(j)  (256  + 64 * (j))
#define XB_XSUB(j)  (1280 + 64 * (j))
#define XB_XGEN(j)  (2304 + 64 * (j))
#define XB_TOP      3328
#define XB_TOPGEN   3392
#define XCD_BAR_WORDS 3456
#define XB_SPIN_CAP (1u << 18)
__device__ __forceinline__ unsigned xb_ld(unsigned* p)              { return __hip_atomic_load(p, __ATOMIC_RELAXED, __HIP_MEMORY_SCOPE_AGENT); }
__device__ __forceinline__ unsigned xb_add(unsigned* p, unsigned v) { return __hip_atomic_fetch_add(p, v, __ATOMIC_RELAXED, __HIP_MEMORY_SCOPE_AGENT); }
__device__ __forceinline__ unsigned xb_xcc_id() { return (unsigned)__builtin_amdgcn_s_getreg((3 << 11) | 20) & 0xFu; }
#define XB_SPIN(cond, bar) do { unsigned _sp = 0; while (cond) { __builtin_amdgcn_s_sleep(1); \
    if ((++_sp & 255u) == 0u) { if (xb_ld(&(bar)[XB_TMO])) break; if (_sp > XB_SPIN_CAP) { atomicAdd(&(bar)[XB_TMO], 1u); break; } } } } while (0)
struct XcdBarrier { unsigned* bar; unsigned x; volatile LAS unsigned* st; };
__device__ __forceinline__ XcdBarrier xcd_barrier_post(unsigned* bar, volatile LAS unsigned* st) {
    XcdBarrier b; b.bar = bar; b.x = xb_xcc_id(); b.st = st;
    if (threadIdx.x == 0) (void)xb_add(&bar[XB_XCNT(b.x)], 1u);
    return b;
}
__device__ __forceinline__ void xcd_barrier_complete(unsigned* bar, unsigned x, unsigned& nloc, unsigned& nx) {
    const unsigned G = gridDim.x * gridDim.y * gridDim.z;
    unsigned sum, cnt, mine, sp = 0u;
    for (;;) {
        sum = 0u; cnt = 0u; mine = 0u;
#pragma unroll
        for (unsigned j = 0; j < 16; ++j) { const unsigned c = xb_ld(&bar[XB_XCNT(j)]); sum += c; cnt += (c > 0u) ? 1u : 0u; mine = (j == x) ? c : mine; }
        if (sum == G) break;
        __builtin_amdgcn_s_sleep(1);
        if ((++sp & 255u) == 0u) { if (xb_ld(&bar[XB_TMO])) break; if (sp > XB_SPIN_CAP) { atomicAdd(&bar[XB_TMO], 1u); break; } }
    }
    nloc = mine > 0u ? mine : 1u; nx = cnt > 0u ? cnt : 1u;
}
__device__ __forceinline__ void xcd_barrier(const XcdBarrier& b) {
    asm volatile("s_waitcnt vmcnt(0)" ::: "memory");
    __syncthreads();
    if (threadIdx.x == 0) {
        unsigned* bar = b.bar;
        __builtin_amdgcn_s_waitcnt(0);
        unsigned nloc = b.st[0], nx = b.st[1];
        if (nloc == 0u) { xcd_barrier_complete(bar, b.x, nloc, nx); b.st[0] = nloc; b.st[1] = nx; }
        const unsigned old = xb_add(&bar[XB_XSUB(b.x)], 1u);
        const unsigned gen = old / nloc;
        if (old + 1u == (gen + 1u) * nloc) {
            __builtin_amdgcn_fence(__ATOMIC_RELEASE, "agent");
            asm volatile("s_waitcnt vmcnt(0)" ::: "memory");
            const unsigned og = xb_add(&bar[XB_TOP], 1u);
            const unsigned tg = og / nx;
            if (og + 1u == (tg + 1u) * nx) xb_add(&bar[XB_TOPGEN], 1u);
            else XB_SPIN(xb_ld(&bar[XB_TOPGEN]) == tg, bar);
            __builtin_amdgcn_fence(__ATOMIC_ACQUIRE, "agent");
            xb_add(&bar[XB_XGEN(b.x)], 1u);
            asm volatile("s_waitcnt vmcnt(0)" ::: "memory");
        } else {
            XB_SPIN(xb_ld(&bar[XB_XGEN(b.x)]) == gen, bar);
            __builtin_amdgcn_fence(__ATOMIC_ACQUIRE, "agent");
            asm volatile("s_waitcnt vmcnt(0)" ::: "memory");
        }
    }
    __syncthreads();
}

struct Args { const float* in[23]; float* out; unsigned char* ws; int ph_lo, ph_hi, li, pad; };
struct Frame {
    LAS unsigned char* lds; int tid, lane, wave, bid, G, gw, NGW;
};
#define LDS_WAIT() asm volatile("s_waitcnt lgkmcnt(0)" ::: "memory")

__device__ __forceinline__ const float* kp_in(int k) { int kv = k; asm volatile("" : "+v"(kv)); const char __attribute__((address_space(4)))* kp = (const char __attribute__((address_space(4)))*)__builtin_amdgcn_kernarg_segment_ptr();
    return *(const float* const __attribute__((address_space(4)))*)(kp + 8 * kv); }
constexpr int P0_MODU = 96;
__device__ __forceinline__ void p0_mod_unit(const Frame& F, const Args& a, int unit) {
    const float* c = kp_in(1); const float* w_mod = kp_in(2); const float* b_mod = kp_in(3); float* mod = (float*)(a.ws + WS_MOD);
    LAS float* cs = (LAS float*)F.lds;
    LAS float* red = (LAS float*)(F.lds + 32768);
    for (int i = F.tid; i < 4 * 2048; i += NTHREADS) { const float v = c[i]; cs[i] = v / (1.f + __expf(-v)); }
    __syncthreads();
    const int l = unit / 48, cb = (unit % 48) * 256; const int n4 = F.lane * 4;
    const float* w = w_mod + (size_t)l * D * MODW + cb + n4;
    f32x4 acc[4] = {{0, 0, 0, 0}, {0, 0, 0, 0}, {0, 0, 0, 0}, {0, 0, 0, 0}};
#pragma unroll 16
    for (int i = 0; i < 256; ++i) { const int k = F.wave * 256 + i; const f32x4 wv = __builtin_nontemporal_load((const f32x4*)(w + (size_t)k * MODW));
#pragma unroll
        for (int b = 0; b < 4; ++b) acc[b] += wv * cs[b * 2048 + k]; }
#pragma unroll
    for (int b = 0; b < 4; ++b) *(LAS f32x4*)(red + (F.wave * 4 + b) * 256 + n4) = acc[b];
    __syncthreads();
    for (int o = F.tid; o < 1024; o += NTHREADS) { const int b = o >> 8, n = o & 255; float s2 = 0.f;
#pragma unroll
        for (int w8 = 0; w8 < 8; ++w8) s2 += red[(w8 * 4 + b) * 256 + n];
        mod[(size_t)(l * 4 + b) * MODW + cb + n] = s2 + b_mod[l * MODW + cb + n]; }
    __syncthreads();
}
struct P0Item { const float* src; unsigned char* dst; int N, dpitch, fp8; float sc; };
constexpr int IT_IN = 3072, IT_OUT = 1024, IT_E = 65 * 256;
#ifndef NWORK
#define NWORK 0
#endif
constexpr int PSEG0 = IT_IN, PSEG1 = PSEG0 + IT_OUT, PSEG2 = PSEG1 + 2 * IT_E, PSEG3 = PSEG2 + IT_E, PITEMS = PSEG3;
constexpr int WSEG0 = IT_IN, WSEG1 = WSEG0 + IT_OUT, WSEG2 = WSEG1 + 2 * IT_E, WSEG3 = WSEG2 + IT_E, WITEMS = WSEG3;
enum { TT_IN = 0, TT_OUT = 1, TT_W1 = 2, TT_W2 = 3 };
__device__ __forceinline__ P0Item p0_tile_desc(const Args& a, int l, int type, int r) {
    unsigned char* ws = a.ws; P0Item d;
    if (type == TT_IN) { const bool f8 = (DENSE1_FP8 && l == 1) || (DENSE0_QKV8 && l == 0); const float* m = kp_in(6) + (size_t)l * D * 3 * D; d.N = 3 * D;
        if (f8) { const int kt = r / 192, nt = r % 192; d.src = m + (size_t)kt * 128 * 3 * D + nt * 32; d.dst = ws + WS_WIN + (size_t)l * 24 * MiB + ((size_t)nt * 32) * D + kt * 128; d.dpitch = D; d.fp8 = 1; d.sc = WD_SC; }
        else { const int kt = r / 96, nt = r % 96; d.src = m + (size_t)kt * 64 * 3 * D + nt * 64; d.dst = ws + WS_WIN + (((size_t)l * 3 * D + nt * 64) * D + kt * 64) * 2; d.dpitch = D * 2; d.fp8 = 0; d.sc = 1.f; }
        return d; }
    if (type == TT_OUT) { const bool f8 = (DENSE1_FP8 && l == 1) || (DENSE0_OUT8 && l == 0); const float* m = kp_in(7) + (size_t)l * D * D; d.N = D;
        if (f8) { const int kt = r / 64, nt = r % 64; d.src = m + (size_t)kt * 128 * D + nt * 32; d.dst = ws + WS_WOUT + (size_t)l * 8 * MiB + ((size_t)nt * 32) * D + kt * 128; d.dpitch = D; d.fp8 = 1; d.sc = WD_SC; }
        else { const int kt = r / 32, nt = r % 32; d.src = m + (size_t)kt * 64 * D + nt * 64; d.dst = ws + WS_WOUT + (((size_t)l * D + nt * 64) * D + kt * 64) * 2; d.dpitch = D * 2; d.fp8 = 0; d.sc = 1.f; }
        return d; }
    if (type == TT_W1) { const int up = r / IT_E; r %= IT_E; const int e = r / 256, kt = (r % 256) / 16, nt = r % 16;
        const float* m = (e < NE) ? kp_in(up ? 18 : 17) + ((size_t)l * NE + e) * D * EF : kp_in(up ? 21 : 20) + (size_t)l * D * EF;
        const int n0 = nt * 32, drow = (n0 / 128) * 256 + up * 128 + (n0 % 128);
        d.src = m + (size_t)kt * 128 * EF + n0; d.N = EF; d.dst = ws + WS_W1 + (((size_t)l * 65 + e) * 1024 + drow) * D + kt * 128; d.dpitch = D; d.fp8 = 1; d.sc = W1_SC; return d; }
    { const int e = r / 256, kt = (r % 256) / 64, nt = r % 64;
        const float* m = (e < NE) ? kp_in(19) + ((size_t)l * NE + e) * EF * D : kp_in(22) + (size_t)l * EF * D;
        d.src = m + (size_t)kt * 128 * D + nt * 32; d.N = D; d.dst = ws + WS_W2 + (((size_t)l * 65 + e) * D + nt * 32) * EF + kt * 128; d.dpitch = EF; d.fp8 = 1; d.sc = W2_SC; return d; }
}
__device__ __forceinline__ P0Item p0_decode_l(const Args& a, int l, int i) {
    if (i < WSEG0) return p0_tile_desc(a, l, TT_IN, i);
    if (i < WSEG1) return p0_tile_desc(a, l, TT_OUT, i - WSEG0);
    if (i < WSEG2) return p0_tile_desc(a, l, TT_W1, i - WSEG1);
    return p0_tile_desc(a, l, TT_W2, i - WSEG2);
}
__device__ __forceinline__ P0Item p0_decode_w(const Args& a, int i) { return p0_decode_l(a, 1, i); }
#define P0_LOAD(d, v) do { const int g_ = (d).fp8 ? (lane >> 3) : (lane >> 4), c_ = (d).fp8 ? (lane & 7) * 4 : (lane & 15) * 4; \
    _Pragma("unroll") for (int i_ = 0; i_ < 16; ++i_) v[i_] = __builtin_nontemporal_load((const f32x4*)((d).src + (size_t)(16 * g_ + i_) * (d).N + c_)); } while (0)
__device__ __forceinline__ void p0_store(const P0Item& d, const f32x4 (&v)[16], int lane) {
    if (d.fp8) { const int g = lane >> 3, nb = (lane & 7) * 4;
#pragma unroll
        for (int j = 0; j < 4; ++j) { u32x4 o;
            o.x = pk4_fp8(v[0][j] * d.sc, v[1][j] * d.sc, v[2][j] * d.sc, v[3][j] * d.sc); o.y = pk4_fp8(v[4][j] * d.sc, v[5][j] * d.sc, v[6][j] * d.sc, v[7][j] * d.sc);
            o.z = pk4_fp8(v[8][j] * d.sc, v[9][j] * d.sc, v[10][j] * d.sc, v[11][j] * d.sc); o.w = pk4_fp8(v[12][j] * d.sc, v[13][j] * d.sc, v[14][j] * d.sc, v[15][j] * d.sc);
            *(u32x4*)(d.dst + (size_t)(nb + j) * d.dpitch + 16 * g) = o; }
    } else { const int g = lane >> 4, nb = (lane & 15) * 4;
#pragma unroll
        for (int j = 0; j < 4; ++j) { u32x4 o0, o1;
            o0.x = cvt_pk_bf16(v[0][j], v[1][j]); o0.y = cvt_pk_bf16(v[2][j], v[3][j]); o0.z = cvt_pk_bf16(v[4][j], v[5][j]); o0.w = cvt_pk_bf16(v[6][j], v[7][j]);
            o1.x = cvt_pk_bf16(v[8][j], v[9][j]); o1.y = cvt_pk_bf16(v[10][j], v[11][j]); o1.z = cvt_pk_bf16(v[12][j], v[13][j]); o1.w = cvt_pk_bf16(v[14][j], v[15][j]);
            unsigned char* p = d.dst + (size_t)(nb + j) * d.dpitch + 32 * g; *(u32x4*)p = o0; *(u32x4*)(p + 16) = o1; }
    }
}
struct P0W { const float* src; unsigned char* dst; int N, dpitch, nt, up, w1; float sc; };
constexpr int P0W_IN = 8 * 24, P0W_OUT = 8 * 8, P0W_E1 = 16 * 65, P0W_E2 = 16 * 65, P0W_L = P0W_IN + P0W_OUT + 2 * P0W_E1 + P0W_E2, P0W_TOT = 2 * P0W_L;
__device__ __forceinline__ P0W p0w_decode(const Args& a, int it) {
    asm volatile("" : "+v"(it));
    unsigned char* ws = a.ws; P0W d; d.up = 0; d.w1 = 0;
    const int l = it / P0W_L; int r = it % P0W_L;
    if (r < P0W_IN) { const int kt = r / 24, nt = r % 24; d.src = kp_in(6) + (size_t)l * D * 3 * D + (size_t)kt * 256 * 3 * D + nt * 256; d.N = 3 * D; d.nt = nt;
        d.dst = ws + WS_WIN + (size_t)l * 24 * MiB + kt * 256; d.dpitch = D; d.sc = WD_SC; return d; }
    r -= P0W_IN;
    if (r < P0W_OUT) { const int kt = r / 8, nt = r % 8; d.src = kp_in(7) + (size_t)l * D * D + (size_t)kt * 256 * D + nt * 256; d.N = D; d.nt = nt;
        d.dst = ws + WS_WOUT + (size_t)l * 8 * MiB + kt * 256; d.dpitch = D; d.sc = WD_SC; return d; }
    r -= P0W_OUT;
    if (r < 2 * P0W_E1) { const int up = r / P0W_E1; r %= P0W_E1; const int e = r / 16, kt = (r % 16) / 2, nt = r % 2;
        const float* m = (e < NE) ? kp_in(up ? 18 : 17) + ((size_t)l * NE + e) * D * EF : kp_in(up ? 21 : 20) + (size_t)l * D * EF;
        d.src = m + (size_t)kt * 256 * EF + nt * 256; d.N = EF; d.nt = nt; d.up = up; d.w1 = 1;
        d.dst = ws + WS_W1 + (((size_t)l * 65 + e) * 1024) * D + kt * 256; d.dpitch = D; d.sc = W1_SC; return d; }
    r -= 2 * P0W_E1;
    { const int e = r / 16, kt = (r % 16) / 8, nt = r % 8;
        const float* m = (e < NE) ? kp_in(19) + ((size_t)l * NE + e) * EF * D : kp_in(22) + (size_t)l * EF * D;
        d.src = m + (size_t)kt * 256 * D + nt * 256; d.N = D; d.nt = nt;
        d.dst = ws + WS_W2 + (((size_t)l * 65 + e) * D) * EF + kt * 256; d.dpitch = EF; d.sc = W2_SC; return d; }
}
#define P0W_LOAD(d, v, h) do { _Pragma("unroll") for (int i_ = 0; i_ < 16; ++i_) v[i_] = __builtin_nontemporal_load((const f32x4*)((d).src + (size_t)((h) * 128 + 16 * w + i_) * (d).N + 4 * lane)); } while (0)
constexpr int P0W_PITCH = 256;
__device__ __forceinline__ void p0w_pack(const Frame& F, float sc, const f32x4 (&v)[16], int par, int h, int lane, int w) {
    LAS unsigned char* img = F.lds + par * (256 * P0W_PITCH);
#pragma unroll
    for (int j = 0; j < 4; ++j) { u32x4 o;
        o.x = pk4_fp8(v[0][j] * sc, v[1][j] * sc, v[2][j] * sc, v[3][j] * sc); o.y = pk4_fp8(v[4][j] * sc, v[5][j] * sc, v[6][j] * sc, v[7][j] * sc);
        o.z = pk4_fp8(v[8][j] * sc, v[9][j] * sc, v[10][j] * sc, v[11][j] * sc); o.w = pk4_fp8(v[12][j] * sc, v[13][j] * sc, v[14][j] * sc, v[15][j] * sc);
        const int r = j * 64 + lane; *(LAS u32x4*)(img + r * P0W_PITCH + (((h * 8 + w) ^ (r & 15)) * 16)) = o; }
}
__device__ __forceinline__ void p0w_store(const Frame& F, const P0W& d, int par, int lane, int w) {
    LAS unsigned char* img = F.lds + par * (256 * P0W_PITCH);
#pragma unroll
    for (int s2 = 0; s2 < 8; ++s2) { const int r = 32 * w + 4 * s2 + (lane >> 4), c = lane & 15; const u32x4 val = *(const LAS u32x4*)(img + r * P0W_PITCH + ((c ^ (r & 15)) * 16));
        const int ng = d.nt * 256 + 4 * (r & 63) + (r >> 6); const int row = d.w1 ? ((ng >> 7) * 256 + d.up * 128 + (ng & 127)) : ng;
        __builtin_nontemporal_store(val, (u32x4*)(d.dst + (size_t)row * d.dpitch + 16 * c)); }
}
__device__ __forceinline__ void p0_convert_stream(const Frame& F, const Args& a) {
    const int lane = (int)(threadIdx.x & 63u); const int w = __builtin_amdgcn_readfirstlane((int)(threadIdx.x >> 6)); f32x4 va[16], vb[16]; int par = 0; const int G = (int)gridDim.x, bid = (int)blockIdx.x;
    static_assert(2 * 256 * P0W_PITCH <= RING_BYTES, "prologue images must stay below the table / control words");
    constexpr int P0W_XTRA = 8; const int E = G > P0_MODU ? G - P0_MODU : 0, X = P0W_XTRA * E; const bool ex = bid >= P0_MODU;
#define P0W_IT(v) ((ex && (v) < P0W_XTRA) ? (bid - P0_MODU) + E * (v) : X + bid + G * ((v) - (ex ? P0W_XTRA : 0)))
    __syncthreads();
    int v = 0, it = P0W_IT(0);
    if (it < P0W_TOT) { const P0W d = p0w_decode(a, it); P0W_LOAD(d, va, 0); }
    while (it < P0W_TOT) {
        { const P0W d = p0w_decode(a, it); P0W_LOAD(d, vb, 1); p0w_pack(F, d.sc, va, par, 0, lane, w); }
        const int itn = P0W_IT(v + 1);
        if (itn < P0W_TOT) { const P0W d = p0w_decode(a, itn); P0W_LOAD(d, va, 0); }
        { const P0W d = p0w_decode(a, it); p0w_pack(F, d.sc, vb, par, 1, lane, w); __syncthreads(); p0w_store(F, d, par, lane, w); }
        par ^= 1; it = itn; ++v;
    }
#undef P0W_IT
    __syncthreads();
}
#ifndef P0_STREAM
#define P0_STREAM 1
#endif
__device__ __forceinline__ void p0_prologue(const Frame& F, const Args& a) {
    for (int mu = F.bid; mu < P0_MODU; mu += F.G) p0_mod_unit(F, a, mu);
    const int lane = F.lane;
#if P0_STREAM && DENSE1_FP8 && DENSE0_QKV8 && DENSE0_OUT8 && NWORK == 0
    p0_convert_stream(F, a);
    constexpr int PTOT = 0;
    f32x4 va[16], vb[16]; P0Item da, db;
    int it = F.gw;
#else
    f32x4 va[16], vb[16]; P0Item da, db;
    int it = F.gw;
    constexpr int PTOT = (NWORK > 0 ? 1 : 2) * PITEMS;
#endif
    if (it < PTOT) { da = p0_decode_l(a, it / PITEMS, it % PITEMS); P0_LOAD(da, va); }
    while (it < PTOT) {
        int itn = it + F.NGW;
        if (itn < PTOT) { db = p0_decode_l(a, itn / PITEMS, itn % PITEMS); P0_LOAD(db, vb); }
        p0_store(da, va, lane);
        it = itn; if (it >= PTOT) break;
        itn = it + F.NGW;
        if (itn < PTOT) { da = p0_decode_l(a, itn / PITEMS, itn % PITEMS); P0_LOAD(da, va); }
        p0_store(db, vb, lane);
        it = itn;
    }
#ifdef PROBE_P0R
    { f32x4 acc_ = {0.f, 0.f, 0.f, 0.f};
      for (int i2 = F.gw; i2 < PTOT; i2 += F.NGW) { const P0Item d2 = p0_decode_l(a, i2 / PITEMS, i2 % PITEMS); f32x4 v2[16]; P0_LOAD(d2, v2);
#pragma unroll
          for (int q = 0; q < 16; ++q) acc_ += v2[q]; }
      if (acc_[0] + acc_[1] + acc_[2] + acc_[3] == 123456.789f) ((float*)(a.ws + WS_LOGIT))[F.tid] = acc_[0]; }
#endif
    for (int r = F.gw; r < 512; r += F.NGW) {
        const int l = r >> 8, rr = r & 255; bf16_t* dst = (bf16_t*)(a.ws + WS_WR) + ((size_t)l * 256 + rr) * D; const float* src = kp_in(15) + ((size_t)l * NE + rr) * D;
#pragma unroll
        for (int j = 0; j < 4; ++j) { const int k = (j * 64 + lane) * 8; u32x4 o = {0u, 0u, 0u, 0u};
            if (rr < NE) { const f32x4 x0 = *(const f32x4*)(src + k), x1 = *(const f32x4*)(src + k + 4); o.x = cvt_pk_bf16(x0[0], x0[1]); o.y = cvt_pk_bf16(x0[2], x0[3]); o.z = cvt_pk_bf16(x1[0], x1[1]); o.w = cvt_pk_bf16(x1[2], x1[3]); }
            *(u32x4*)(dst + k) = o; } }
    int* tok = (int*)(a.ws + WS_TOK);
    for (int t = F.bid * NTHREADS + F.tid; t < T; t += F.G * NTHREADS) tok[NSR + t] = t;
}
__device__ __forceinline__ void worker_phase(const Frame& F, const Args& a, int p, int need, int& nxt, int wstride, int ncompute) {
    volatile LAS int* go = (volatile LAS int*)(F.lds + TAB_MISC + 512);
    unsigned* done = (unsigned*)(a.ws + WS_CTL) + 1024 + 64 * p;
    const int lane = F.lane; int polls = 0;
    for (;;) {
        const bool must = nxt < need;
        if (!must && go[0] == p + 1) break;
        if (nxt < WITEMS) {
            f32x4 va[16], vb[16]; const int n2 = nxt + wstride; const bool two = n2 < WITEMS;
            const P0Item da = p0_decode_w(a, nxt); P0_LOAD(da, va);
            if (two) { const P0Item db = p0_decode_w(a, n2); P0_LOAD(db, vb); p0_store(da, va, lane); p0_store(db, vb, lane); nxt = n2 + wstride; }
            else { p0_store(da, va, lane); nxt = n2; }
        } else __builtin_amdgcn_s_sleep(32);
        if (F.wave == 0 && ((++polls & 3) == 0 || nxt >= WITEMS)) { const unsigned v = __hip_atomic_load(done, __ATOMIC_RELAXED, __HIP_MEMORY_SCOPE_AGENT); if (v >= (unsigned)ncompute) go[0] = p + 1; }
    }
}

template <bool INBF> __device__ __forceinline__ void phase_norm(const Frame& F, const void* x, const float* g, const float* modl, int ish, int isc, bf16_t* XN, unsigned char* XN8) {
    float gs[4][8], shv[4][8]; int bcur = -1;
    const int rpw = (T + F.NGW - 1) / F.NGW, t0 = F.gw * rpw, t1 = (t0 + rpw < T) ? t0 + rpw : T;
    for (int t = t0; t < t1; ++t) { const int b = t / S;
        if (b != bcur) { bcur = b; const float* sh = modl + (size_t)b * MODW + ish * D; const float* sc = modl + (size_t)b * MODW + isc * D;
#pragma unroll
            for (int j = 0; j < 4; ++j) { const int d = (j * 64 + F.lane) * 8;
#pragma unroll
                for (int hh = 0; hh < 2; ++hh) { const f32x4 gv = *(const f32x4*)(g + d + 4 * hh), s1 = *(const f32x4*)(sc + d + 4 * hh), s0 = *(const f32x4*)(sh + d + 4 * hh);
#pragma unroll
                    for (int i = 0; i < 4; ++i) { gs[j][4 * hh + i] = gv[i] * (1.f + s1[i]); shv[j][4 * hh + i] = s0[i]; } } } }
        float v[4][8]; float ss = 0.f;
#pragma unroll
        for (int j = 0; j < 4; ++j) { const int d = (j * 64 + F.lane) * 8;
            if (INBF) { const u32x4 w = *(const u32x4*)((const bf16_t*)x + (size_t)t * D + d); v[j][0] = bf_lo(w.x); v[j][1] = bf_hi(w.x); v[j][2] = bf_lo(w.y); v[j][3] = bf_hi(w.y); v[j][4] = bf_lo(w.z); v[j][5] = bf_hi(w.z); v[j][6] = bf_lo(w.w); v[j][7] = bf_hi(w.w); }
            else { const f32x4 a0 = *(const f32x4*)((const float*)x + (size_t)t * D + d), a1 = *(const f32x4*)((const float*)x + (size_t)t * D + d + 4); v[j][0] = a0[0]; v[j][1] = a0[1]; v[j][2] = a0[2]; v[j][3] = a0[3]; v[j][4] = a1[0]; v[j][5] = a1[1]; v[j][6] = a1[2]; v[j][7] = a1[3]; }
#pragma unroll
            for (int i = 0; i < 8; ++i) ss += v[j][i] * v[j][i]; }
        const float r = rsqrtf(wave_sum(ss) * (1.f / D) + EPS);
#pragma unroll
        for (int j = 0; j < 4; ++j) { const int d = (j * 64 + F.lane) * 8; float y[8];
#pragma unroll
            for (int i = 0; i < 8; ++i) y[i] = v[j][i] * r * gs[j][i] + shv[j][i];
            if (XN) { u32x4 o; o.x = cvt_pk_bf16(y[0], y[1]); o.y = cvt_pk_bf16(y[2], y[3]); o.z = cvt_pk_bf16(y[4], y[5]); o.w = cvt_pk_bf16(y[6], y[7]); *(u32x4*)(XN + (size_t)t * D + d) = o; }
            if (XN8) { u32x2 o8; o8.x = pk4_fp8(y[0], y[1], y[2], y[3]); o8.y = pk4_fp8(y[4], y[5], y[6], y[7]); *(u32x2*)(XN8 + (size_t)t * D + d) = o8; } }
    }
}
__device__ __forceinline__ void phase_norm_x(const Frame& F, const float* x, const float* g, const float* modl, int ish, int isc, unsigned char* XN8) {
    f32x4 gs[8], shv[8]; int bcur = -1;
    const int rpw = (T + F.NGW - 1) / F.NGW, t0 = F.gw * rpw, t1 = (t0 + rpw < T) ? t0 + rpw : T;
    for (int t = t0; t < t1; ++t) { const int b = t / S;
        if (b != bcur) { bcur = b; const float* sh = modl + (size_t)b * MODW + ish * D; const float* sc = modl + (size_t)b * MODW + isc * D;
#pragma unroll
            for (int i = 0; i < 8; ++i) { const int d = 256 * i + 4 * F.lane; const f32x4 gv = *(const f32x4*)(g + d), s1 = *(const f32x4*)(sc + d); gs[i] = gv * (1.f + s1); shv[i] = *(const f32x4*)(sh + d); } }
        f32x4 v[8]; float ss = 0.f;
#pragma unroll
        for (int i = 0; i < 8; ++i) v[i] = __builtin_nontemporal_load((const f32x4*)(x + (size_t)t * D + 256 * i + 4 * F.lane));
#pragma unroll
        for (int i = 0; i < 8; ++i) ss += v[i][0] * v[i][0] + v[i][1] * v[i][1] + v[i][2] * v[i][2] + v[i][3] * v[i][3];
        const float r = rsqrtf(wave_sum(ss) * (1.f / D) + EPS);
#pragma unroll
        for (int i = 0; i < 8; ++i) { const f32x4 y = v[i] * r * gs[i] + shv[i];
            *(unsigned*)(XN8 + (size_t)t * D + 256 * i + 4 * F.lane) = pk4_fp8(y[0], y[1], y[2], y[3]); }
    }
}
__device__ __forceinline__ void phase_qknorm(const Frame& F, bf16_t* QKV, const float* qn, const float* kn) {
    for (int t = F.gw; t < T; t += F.NGW) { bf16_t* row = QKV + (size_t)t * (3 * D);
#pragma unroll
        for (int j = 0; j < 8; ++j) { const int e0 = (j * 64 + F.lane) * 8; const u32x4 w = *(const u32x4*)(row + e0);
            float x[8] = {bf_lo(w.x), bf_hi(w.x), bf_lo(w.y), bf_hi(w.y), bf_lo(w.z), bf_hi(w.z), bf_lo(w.w), bf_hi(w.w)}; float ss = 0.f;
#pragma unroll
            for (int i = 0; i < 8; ++i) ss += x[i] * x[i];
            ss += __shfl_xor(ss, 1); ss += __shfl_xor(ss, 2); ss += __shfl_xor(ss, 4); ss += __shfl_xor(ss, 8);
            const float r = rsqrtf(ss * (1.f / 128.f) + EPS); const float* wv = (e0 < D ? qn : kn) + (e0 & 127);
            u32x4 o; o.x = cvt_pk_bf16(x[0] * r * wv[0], x[1] * r * wv[1]); o.y = cvt_pk_bf16(x[2] * r * wv[2], x[3] * r * wv[3]); o.z = cvt_pk_bf16(x[4] * r * wv[4], x[5] * r * wv[5]); o.w = cvt_pk_bf16(x[6] * r * wv[6], x[7] * r * wv[7]);
            *(u32x4*)(row + e0) = o; } }
}
__device__ __forceinline__ void phase_dacombine(const Frame& F, const bf16_t* OT, const Args& a, float lambda_init, bf16_t* O) {
    const float* lq1 = a.in[10]; const float* lk1 = a.in[11]; const float* lq2 = a.in[12]; const float* lk2 = a.in[13]; const float* subln = a.in[14];
    float s1 = lq1[F.lane] * lk1[F.lane] + lq1[F.lane + 64] * lk1[F.lane + 64], s2 = lq2[F.lane] * lk2[F.lane] + lq2[F.lane + 64] * lk2[F.lane + 64];
    s1 = wave_sum(s1); s2 = wave_sum(s2);
    const float lam = __expf(s1) - __expf(s2) + lambda_init;
    for (int t = F.gw; t < T; t += F.NGW) {
#pragma unroll
        for (int j = 0; j < 4; ++j) { const int e0 = (j * 64 + F.lane) * 8; const u32x4 w1 = *(const u32x4*)(OT + (size_t)t * D + e0), w2 = *(const u32x4*)(OT + (size_t)(T + t) * D + e0);
            float x[8] = {bf_lo(w1.x) - lam * bf_lo(w2.x), bf_hi(w1.x) - lam * bf_hi(w2.x), bf_lo(w1.y) - lam * bf_lo(w2.y), bf_hi(w1.y) - lam * bf_hi(w2.y),
                          bf_lo(w1.z) - lam * bf_lo(w2.z), bf_hi(w1.z) - lam * bf_hi(w2.z), bf_lo(w1.w) - lam * bf_lo(w2.w), bf_hi(w1.w) - lam * bf_hi(w2.w)}; float ss = 0.f;
#pragma unroll
            for (int i = 0; i < 8; ++i) ss += x[i] * x[i];
            ss += __shfl_xor(ss, 1); ss += __shfl_xor(ss, 2); ss += __shfl_xor(ss, 4); ss += __shfl_xor(ss, 8); ss += __shfl_xor(ss, 16);
            const float r = rsqrtf(ss * (1.f / 256.f) + SUBLN_EPS) * (1.f - lambda_init); const float* wv = subln + (e0 & 255);
            u32x4 o; o.x = cvt_pk_bf16(x[0] * r * wv[0], x[1] * r * wv[1]); o.y = cvt_pk_bf16(x[2] * r * wv[2], x[3] * r * wv[3]); o.z = cvt_pk_bf16(x[4] * r * wv[4], x[5] * r * wv[5]); o.w = cvt_pk_bf16(x[6] * r * wv[6], x[7] * r * wv[7]);
            *(u32x4*)(O + (size_t)t * D + e0) = o; } }
}
__device__ __forceinline__ void phase_route(const Frame& F, const Args& a, int l) {
    const float* logits = (const float*)(a.ws + WS_LOGIT); const float* rbias = a.in[16] + l * NE;
    int* top_e = (int*)(a.ws + WS_TOPE); float* gate = (float*)(a.ws + WS_GATE); int* lpos = (int*)(a.ws + WS_LPOS); int* cnt = (int*)(a.ws + WS_CNT);
    LAS int* hist = (LAS int*)(F.lds + TAB_MISC);
    for (int tile = F.bid; tile < T / 64; tile += F.G) {
        __syncthreads();
        if (F.tid < NE) hist[F.tid] = 0;
        __syncthreads();
        const float bias = rbias[F.lane];
        float lgs[8];
#pragma unroll
        for (int i = 0; i < 8; ++i) { const int t = tile * 64 + F.wave * 8 + i;
            lgs[i] = (logits[(size_t)t * NE + F.lane] + logits[((size_t)T + t) * NE + F.lane]) + (logits[((size_t)2 * T + t) * NE + F.lane] + logits[((size_t)3 * T + t) * NE + F.lane]); }
#pragma unroll
        for (int i = 0; i < 8; ++i) { const int t = tile * 64 + F.wave * 8 + i, lane = F.lane;
            const float lg = lgs[i]; const float sc = 1.f / (1.f + __expf(-lg)); const float bb = sc + bias;
            float m1 = bb; m1 = fmaxf(m1, __shfl_xor(m1, 1)); m1 = fmaxf(m1, __shfl_xor(m1, 2)); m1 = fmaxf(m1, __shfl_xor(m1, 4));
            const unsigned long long eq = __ballot(bb == m1); const int gbase = lane & ~7; const unsigned grpmask = (unsigned)((eq >> gbase) & 0xffull);
            const int first = gbase + __builtin_ctz(grpmask);
            float m2 = (lane == first) ? -INFINITY : bb; m2 = fmaxf(m2, __shfl_xor(m2, 1)); m2 = fmaxf(m2, __shfl_xor(m2, 2)); m2 = fmaxf(m2, __shfl_xor(m2, 4));
            const float gs = m1 + m2; const int g = lane >> 3;
            int grank = 0;
#pragma unroll
            for (int g2 = 0; g2 < 8; ++g2) { const float v = __int_as_float(__builtin_amdgcn_readlane(__float_as_int(gs), g2 * 8)); grank += (v > gs || (v == gs && g2 < g)) ? 1 : 0; }
            const bool keep = grank < 4; const float val = keep ? bb : -INFINITY;
            int rank = 0;
#pragma unroll 8
            for (int e2 = 0; e2 < 64; ++e2) { const float v = __int_as_float(__builtin_amdgcn_readlane(__float_as_int(val), e2)); rank += (v > val || (v == val && e2 < lane)) ? 1 : 0; }
            const bool sel = rank < TOPK;
            const float ssum = wave_sum(sel ? sc : 0.f);
            if (sel) { const int p = atomicAdd((int*)(hist + lane), 1); top_e[t * TOPK + rank] = lane; gate[t * TOPK + rank] = sc / ssum * 2.5f; lpos[t * TOPK + rank] = p; }
        }
        __syncthreads();
        if (F.tid < NE) cnt[tile * NE + F.tid] = hist[F.tid];
    }
}
#ifndef FUSE_NRR
#define FUSE_NRR 1
#endif
__device__ __forceinline__ void phase_nrr(const Frame& F, const Args& a, int l, const bf16_t* XA, const float* g, const float* modl, unsigned char* XN8) {
    const bf16_t* Wr = (const bf16_t*)(a.ws + WS_WR) + (size_t)l * 256 * D; const float* rbias = a.in[16] + l * NE;
    int* top_e = (int*)(a.ws + WS_TOPE); float* gate = (float*)(a.ws + WS_GATE); int* lpos = (int*)(a.ws + WS_LPOS); int* cnt = (int*)(a.ws + WS_CNT);
    LAS int* hist = (LAS int*)(F.lds + TAB_MISC);
    constexpr int APITCH = 2064;
    static_assert(64 * APITCH <= RING_BYTES, "nrr tile");
    LAS unsigned char* At = F.lds; LAS float* Pl = (LAS float*)F.lds;
    const int lane = F.lane, w = F.wave, fr = lane & 15, fq = lane >> 4, eb = w & 3, kq = w >> 2;
    for (int tile = F.bid; tile < T / 64; tile += F.G) {
        const int tb = tile * 64 + w * 8, b = tb / S;
        __syncthreads();
        if (F.tid < NE) hist[F.tid] = 0;
        float rs[8];
#pragma unroll
        for (int i4 = 0; i4 < 2; ++i4) { u32x4 rw[4][4];
#pragma unroll
            for (int i = 0; i < 4; ++i)
#pragma unroll
                for (int j = 0; j < 4; ++j) rw[i][j] = *(const u32x4*)(XA + (size_t)(tb + 4 * i4 + i) * D + (j * 64 + lane) * 8);
#pragma unroll
            for (int i = 0; i < 4; ++i) { float ss = 0.f;
#pragma unroll
                for (int j = 0; j < 4; ++j)
#pragma unroll
                    for (int q = 0; q < 4; ++q) { const float x0 = bf_lo(rw[i][j][q]), x1 = bf_hi(rw[i][j][q]); ss += x0 * x0; ss += x1 * x1; }
                rs[4 * i4 + i] = rsqrtf(wave_sum(ss) * (1.f / D) + EPS); } }
        f32x4 acc[4] = {{0.f, 0.f, 0.f, 0.f}, {0.f, 0.f, 0.f, 0.f}, {0.f, 0.f, 0.f, 0.f}, {0.f, 0.f, 0.f, 0.f}};
        u32x4 raw[8][2];
#pragma unroll
        for (int i = 0; i < 8; ++i)
#pragma unroll
            for (int jj = 0; jj < 2; ++jj) raw[i][jj] = *(const u32x4*)(XA + (size_t)(tb + i) * D + (jj * 64 + lane) * 8);
#pragma unroll 1
        for (int h = 0; h < 2; ++h) {
            const bf16_t* wrow = Wr + (size_t)(16 * eb + fr) * D + h * 1024 + 512 * kq + 8 * fq;
            bf16x8 bv[16];
#pragma unroll
            for (int kb = 0; kb < 16; ++kb) bv[kb] = *(const bf16x8*)(wrow + 32 * kb);
            float gs[2][8], shv[2][8];
#pragma unroll
            for (int jj = 0; jj < 2; ++jj) { const int d = ((2 * h + jj) * 64 + lane) * 8; const float* sh = modl + (size_t)b * MODW + 3 * D; const float* sc = modl + (size_t)b * MODW + 4 * D;
#pragma unroll
                for (int hh = 0; hh < 2; ++hh) { const f32x4 gv = *(const f32x4*)(g + d + 4 * hh), s1 = *(const f32x4*)(sc + d + 4 * hh), s0 = *(const f32x4*)(sh + d + 4 * hh);
#pragma unroll
                    for (int q = 0; q < 4; ++q) { gs[jj][4 * hh + q] = gv[q] * (1.f + s1[q]); shv[jj][4 * hh + q] = s0[q]; } } }
            if (h == 1) __syncthreads();
#pragma unroll
            for (int i = 0; i < 8; ++i)
#pragma unroll
                for (int jj = 0; jj < 2; ++jj) { const u32x4 rw = raw[i][jj]; float y[8];
#pragma unroll
                    for (int q = 0; q < 4; ++q) { y[2 * q] = bf_lo(rw[q]) * rs[i] * gs[jj][2 * q] + shv[jj][2 * q]; y[2 * q + 1] = bf_hi(rw[q]) * rs[i] * gs[jj][2 * q + 1] + shv[jj][2 * q + 1]; }
                    u32x2 o8; o8.x = pk4_fp8(y[0], y[1], y[2], y[3]); o8.y = pk4_fp8(y[4], y[5], y[6], y[7]);
                    *(u32x2*)(XN8 + (size_t)(tb + i) * D + ((2 * h + jj) * 64 + lane) * 8) = o8;
                    u32x4 o; o.x = cvt_pk_bf16(y[0], y[1]); o.y = cvt_pk_bf16(y[2], y[3]); o.z = cvt_pk_bf16(y[4], y[5]); o.w = cvt_pk_bf16(y[6], y[7]);
                    *(LAS u32x4*)(At + (w * 8 + i) * APITCH + (jj * 64 + lane) * 16) = o; }
            if (h == 0) {
#pragma unroll
                for (int i = 0; i < 8; ++i)
#pragma unroll
                    for (int jj = 0; jj < 2; ++jj) raw[i][jj] = *(const u32x4*)(XA + (size_t)(tb + i) * D + ((2 + jj) * 64 + lane) * 8); }
            __syncthreads();
            const LAS unsigned char* arow = At + fr * APITCH + (512 * kq + 8 * fq) * 2;
#pragma unroll
            for (int kb = 0; kb < 16; ++kb) {
#pragma unroll
                for (int rb = 0; rb < 4; ++rb) { const bf16x8 av = *(const LAS bf16x8*)(arow + rb * 16 * APITCH + kb * 64);
                    acc[rb] = __builtin_amdgcn_mfma_f32_16x16x32_bf16(bv[kb], av, acc[rb], 0, 0, 0); } }
        }
        __syncthreads();
#pragma unroll
        for (int rb = 0; rb < 4; ++rb) *(LAS f32x4*)(Pl + (size_t)((kq * 64 + 16 * rb + fr) * NE + 16 * eb + 4 * fq)) = acc[rb];
        __syncthreads();
        const float bias = rbias[lane];
#pragma unroll
        for (int i = 0; i < 8; ++i) { const int t = tb + i;
            const float lg = Pl[(w * 8 + i) * NE + lane] + Pl[(64 + w * 8 + i) * NE + lane]; const float sc = 1.f / (1.f + __expf(-lg)); const float bb = sc + bias;
            float m1 = bb; m1 = fmaxf(m1, __shfl_xor(m1, 1)); m1 = fmaxf(m1, __shfl_xor(m1, 2)); m1 = fmaxf(m1, __shfl_xor(m1, 4));
            const unsigned long long eq = __ballot(bb == m1); const int gbase = lane & ~7; const unsigned grpmask = (unsigned)((eq >> gbase) & 0xffull);
            const int first = gbase + __builtin_ctz(grpmask);
            float m2 = (lane == first) ? -INFINITY : bb; m2 = fmaxf(m2, __shfl_xor(m2, 1)); m2 = fmaxf(m2, __shfl_xor(m2, 2)); m2 = fmaxf(m2, __shfl_xor(m2, 4));
            const float gsum = m1 + m2; const int gq = lane >> 3;
            int grank = 0;
#pragma unroll
            for (int g2 = 0; g2 < 8; ++g2) { const float v = __int_as_float(__builtin_amdgcn_readlane(__float_as_int(gsum), g2 * 8)); grank += (v > gsum || (v == gsum && g2 < gq)) ? 1 : 0; }
            const bool keep = grank < 4; const float val = keep ? bb : -INFINITY;
            int rank = 0;
#pragma unroll 8
            for (int e2 = 0; e2 < 64; ++e2) { const float v = __int_as_float(__builtin_amdgcn_readlane(__float_as_int(val), e2)); rank += (v > val || (v == val && e2 < lane)) ? 1 : 0; }
            const bool sel = rank < TOPK;
            const float ssum = wave_sum(sel ? sc : 0.f);
            if (sel) { const int p = atomicAdd((int*)(hist + lane), 1); top_e[t * TOPK + rank] = lane; gate[t * TOPK + rank] = sc / ssum * 2.5f; lpos[t * TOPK + rank] = p; }
        }
        __syncthreads();
        if (F.tid < NE) cnt[tile * NE + F.tid] = hist[F.tid];
    }
}
__device__ __forceinline__ void phase_sort(const Frame& F, const Args& a) {
    const int* cnt = (const int*)(a.ws + WS_CNT); const int* top_e = (const int*)(a.ws + WS_TOPE); const int* lpos = (const int*)(a.ws + WS_LPOS);
    int* slot_of = (int*)(a.ws + WS_SLOT); int* tok = (int*)(a.ws + WS_TOK); int* tile_e = (int*)(a.ws + WS_TILEE);
    LAS int* part = (LAS int*)F.lds;
    LAS int* off = (LAS int*)(F.lds + 4096);
    LAS int* base = (LAS int*)(F.lds + 8192);
    const int e = F.tid & 63, grp = F.tid >> 6;
    LAS int* pre = (LAS int*)(F.lds + 12288);
    __syncthreads();
    { int s = 0, p = 0;
#pragma unroll
      for (int i = 0; i < 32; ++i) { const int c = cnt[(grp * 32 + i) * NE + e]; s += c; p += (grp * 32 + i < F.bid) ? c : 0; }
      part[grp * 64 + e] = s; if (grp == F.bid / 32) pre[e] = p; }
    __syncthreads();
    if (F.tid < NE) {
        int tot = 0;
#pragma unroll
        for (int g2 = 0; g2 < 8; ++g2) tot += part[g2 * 64 + F.tid];
        const int pad = (tot + 255) / 256 * 256; int inc = pad;
#pragma unroll
        for (int o = 1; o < 64; o <<= 1) { const int v = __shfl_up(inc, o); if (F.tid >= o) inc += v; }
        off[F.tid] = inc - pad; if (F.tid == NE - 1) off[NE] = inc; }
    __syncthreads();
    if (F.bid == 0) {
        int nrt = off[NE] / 256; nrt = nrt < 0 ? 0 : (nrt > NSR / 256 ? NSR / 256 : nrt);
        if (F.tid < NE) { int r0 = off[F.tid] / 256, r1 = off[F.tid + 1] / 256; r0 = r0 < 0 ? 0 : r0; r1 = r1 > nrt ? nrt : r1; for (int rt = r0; rt < r1; ++rt) tile_e[rt] = F.tid; }
        for (int rt = nrt + F.tid; rt < NRT_MAX; rt += NTHREADS) tile_e[rt] = -1;
        if (F.tid == 0) tile_e[NRT_MAX] = nrt;
    }
    for (int tile = F.bid; tile < T / 64; tile += F.G) {
        __syncthreads();
        if (F.tid < NE) { int s = off[e]; const int g0 = tile / 32; for (int g2 = 0; g2 < g0; ++g2) s += part[g2 * 64 + e];
            if (tile == F.bid) s += pre[e]; else { for (int i = g0 * 32; i < tile; ++i) s += cnt[i * NE + e]; }
            base[e] = s; }
        __syncthreads();
        if (F.tid < 64 * TOPK) { const int i = tile * 64 * TOPK + F.tid; int sl = base[top_e[i]] + lpos[i]; if (sl < 0 || sl >= NSR) sl = NSR - 1;
            slot_of[i] = sl; tok[sl] = i / TOPK; }
    }
}
__device__ __forceinline__ void phase_combine_out(const Frame& F, const Args& a, const bf16_t* x1, const float* modl, float* outf) {
    const int* slot_of = (const int*)(a.ws + WS_SLOT); const float* gate = (const float*)(a.ws + WS_GATE);
    const unsigned char* Y = a.ws + WS_Y;
    int sl[TOPK + 1]; float gw[TOPK + 1];
    const int rpw = (T + F.NGW - 1) / F.NGW, t0 = F.gw * rpw, t1 = (t0 + rpw < T) ? t0 + rpw : T;
    int t = t0;
    if (t < t1) {
#pragma unroll
        for (int k = 0; k < TOPK; ++k) { sl[k] = slot_of[t * TOPK + k]; gw[k] = gate[t * TOPK + k]; } }
    f32x4 g2c[8]; int bcur = -1;
    for (; t < t1; ++t) { const int b = t / S;
        if (b != bcur) { bcur = b; const float* g2 = modl + (size_t)b * MODW + 5 * D;
#pragma unroll
            for (int i = 0; i < 8; ++i) g2c[i] = *(const f32x4*)(g2 + 256 * i + 4 * F.lane); }
        sl[TOPK] = NSR + t; gw[TOPK] = 1.f;
        unsigned yw[TOPK + 1][8]; u32x2 xr[8];
#pragma unroll
        for (int k = 0; k <= TOPK; ++k)
#pragma unroll
            for (int i = 0; i < 8; ++i) yw[k][i] = __builtin_nontemporal_load((const unsigned*)(Y + (size_t)sl[k] * D + 256 * i + 4 * F.lane));
#pragma unroll
        for (int i = 0; i < 8; ++i) xr[i] = __builtin_nontemporal_load((const u32x2*)(x1 + (size_t)t * D + 256 * i + 4 * F.lane));
        float gcur[TOPK + 1];
#pragma unroll
        for (int k = 0; k <= TOPK; ++k) gcur[k] = gw[k] * (1.f / Y_SC);
        const int tn = t + 1;
        if (tn < t1) {
#pragma unroll
            for (int k = 0; k < TOPK; ++k) { sl[k] = slot_of[tn * TOPK + k]; gw[k] = gate[tn * TOPK + k]; } }
#pragma unroll
        for (int i = 0; i < 8; ++i) { float y0 = 0.f, y1 = 0.f, y2 = 0.f, y3 = 0.f;
#pragma unroll
            for (int k = 0; k <= TOPK; ++k) { const f32x2 lo = __builtin_amdgcn_cvt_pk_f32_fp8((int)yw[k][i], false), hi2 = __builtin_amdgcn_cvt_pk_f32_fp8((int)yw[k][i], true); const float gk = gcur[k];
                y0 += gk * lo[0]; y1 += gk * lo[1]; y2 += gk * hi2[0]; y3 += gk * hi2[1]; }
            f32x4 o; o[0] = bf_lo(xr[i].x) + g2c[i][0] * y0; o[1] = bf_hi(xr[i].x) + g2c[i][1] * y1; o[2] = bf_lo(xr[i].y) + g2c[i][2] * y2; o[3] = bf_hi(xr[i].y) + g2c[i][3] * y3;
            *(f32x4*)(outf + (size_t)t * D + 256 * i + 4 * F.lane) = o; }
    }
}
__device__ __forceinline__ void phase_combine(const Frame& F, const Args& a, const bf16_t* x1, const float* modl, float* outf, bf16_t* outb, const float* gn, const float* modn, bf16_t* XN, unsigned char* XN8) {
    const int* slot_of = (const int*)(a.ws + WS_SLOT); const float* gate = (const float*)(a.ws + WS_GATE);
    const unsigned char* Y = a.ws + WS_Y;
    int sl[TOPK + 1]; float gw[TOPK + 1];
    const int rpw = (T + F.NGW - 1) / F.NGW, t0 = F.gw * rpw, t1 = (t0 + rpw < T) ? t0 + rpw : T;
    LAS float* gsl = (LAS float*)F.lds; LAS float* shl = gsl + D; const int bwg = (F.bid * NWAVES * rpw) / S;
    if (gn) { __syncthreads(); const float* sh_ = modn + (size_t)bwg * MODW; const float* sc_ = sh_ + D;
        for (int d = F.tid; d < D; d += NTHREADS) { gsl[d] = gn[d] * (1.f + sc_[d]); shl[d] = sh_[d]; }
        __syncthreads(); }
    int t = t0;
    if (t < t1) {
#pragma unroll
        for (int k = 0; k < TOPK; ++k) { sl[k] = slot_of[t * TOPK + k]; gw[k] = gate[t * TOPK + k]; } }
    float g2c[2][16]; int bcur = -1;
    for (; t < t1; ++t) { const int b = t / S;
        if (b != bcur) { bcur = b; const float* g2 = modl + (size_t)b * MODW + 5 * D;
#pragma unroll
            for (int j = 0; j < 2; ++j)
#pragma unroll
                for (int q = 0; q < 4; ++q) { const f32x4 ga = *(const f32x4*)(g2 + j * 1024 + F.lane * 16 + 4 * q); g2c[j][4 * q] = ga[0]; g2c[j][4 * q + 1] = ga[1]; g2c[j][4 * q + 2] = ga[2]; g2c[j][4 * q + 3] = ga[3]; } }
        sl[TOPK] = NSR + t; gw[TOPK] = 1.f;
        u32x4 yw[TOPK + 1][2]; u32x4 xr[4];
#pragma unroll
        for (int k = 0; k <= TOPK; ++k) { yw[k][0] = __builtin_nontemporal_load((const u32x4*)(Y + (size_t)sl[k] * D + F.lane * 16)); yw[k][1] = __builtin_nontemporal_load((const u32x4*)(Y + (size_t)sl[k] * D + 1024 + F.lane * 16)); }
#pragma unroll
        for (int q = 0; q < 4; ++q) xr[q] = *(const u32x4*)(x1 + (size_t)t * D + (q >> 1) * 1024 + F.lane * 16 + (q & 1) * 8);
        float gcur[TOPK + 1];
#pragma unroll
        for (int k = 0; k <= TOPK; ++k) gcur[k] = gw[k] * (1.f / Y_SC);
        const int tn = t + 1;
        if (tn < t1) {
#pragma unroll
            for (int k = 0; k < TOPK; ++k) { sl[k] = slot_of[tn * TOPK + k]; gw[k] = gate[tn * TOPK + k]; } }
        float xo[2][16]; float ss = 0.f;
#pragma unroll
        for (int j = 0; j < 2; ++j) { const int e0 = j * 1024 + F.lane * 16; float y[16];
#pragma unroll
            for (int i = 0; i < 16; ++i) y[i] = 0.f;
#pragma unroll
            for (int k = 0; k <= TOPK; ++k) { const u32x4 w = yw[k][j]; const float gk = gcur[k];
#pragma unroll
                for (int q = 0; q < 4; ++q) { const f32x2 lo = __builtin_amdgcn_cvt_pk_f32_fp8((int)w[q], false), hi2 = __builtin_amdgcn_cvt_pk_f32_fp8((int)w[q], true);
                    y[4 * q + 0] += gk * lo[0]; y[4 * q + 1] += gk * lo[1]; y[4 * q + 2] += gk * hi2[0]; y[4 * q + 3] += gk * hi2[1]; } }
            float xv[16];
#pragma unroll
            for (int hh = 0; hh < 2; ++hh) { const u32x4 w = xr[j * 2 + hh]; xv[8 * hh + 0] = bf_lo(w.x); xv[8 * hh + 1] = bf_hi(w.x); xv[8 * hh + 2] = bf_lo(w.y); xv[8 * hh + 3] = bf_hi(w.y); xv[8 * hh + 4] = bf_lo(w.z); xv[8 * hh + 5] = bf_hi(w.z); xv[8 * hh + 6] = bf_lo(w.w); xv[8 * hh + 7] = bf_hi(w.w); }
#pragma unroll
            for (int q = 0; q < 4; ++q) {
#pragma unroll
                for (int i = 0; i < 4; ++i) { const float r = xv[4 * q + i] + g2c[j][4 * q + i] * y[4 * q + i]; xo[j][4 * q + i] = r; ss += r * r; }
                if (outf) *(f32x4*)(outf + (size_t)t * D + e0 + 4 * q) = (f32x4){xo[j][4 * q], xo[j][4 * q + 1], xo[j][4 * q + 2], xo[j][4 * q + 3]}; }
            if (outb) { u32x4 w0, w1; w0.x = cvt_pk_bf16(xo[j][0], xo[j][1]); w0.y = cvt_pk_bf16(xo[j][2], xo[j][3]); w0.z = cvt_pk_bf16(xo[j][4], xo[j][5]); w0.w = cvt_pk_bf16(xo[j][6], xo[j][7]);
                w1.x = cvt_pk_bf16(xo[j][8], xo[j][9]); w1.y = cvt_pk_bf16(xo[j][10], xo[j][11]); w1.z = cvt_pk_bf16(xo[j][12], xo[j][13]); w1.w = cvt_pk_bf16(xo[j][14], xo[j][15]);
                *(u32x4*)(outb + (size_t)t * D + e0) = w0; *(u32x4*)(outb + (size_t)t * D + e0 + 8) = w1; } }
        if (gn) { const float r = rsqrtf(wave_sum(ss) * (1.f / D) + EPS); const float* sh = modn + (size_t)b * MODW; const float* sc = sh + D;
#pragma unroll
            for (int j = 0; j < 2; ++j) { const int e0 = j * 1024 + F.lane * 16; u32x4 w0, w1; float yv[16];
                if (b == bwg) {
#pragma unroll
                    for (int q = 0; q < 4; ++q) { const f32x4 gv = *(const LAS f32x4*)(gsl + e0 + 4 * q), s0 = *(const LAS f32x4*)(shl + e0 + 4 * q);
#pragma unroll
                        for (int i = 0; i < 4; ++i) yv[4 * q + i] = xo[j][4 * q + i] * r * gv[i] + s0[i]; }
                } else {
#pragma unroll
                    for (int q = 0; q < 4; ++q) { const f32x4 gv = *(const f32x4*)(gn + e0 + 4 * q), s1 = *(const f32x4*)(sc + e0 + 4 * q), s0 = *(const f32x4*)(sh + e0 + 4 * q);
#pragma unroll
                        for (int i = 0; i < 4; ++i) yv[4 * q + i] = xo[j][4 * q + i] * r * gv[i] * (1.f + s1[i]) + s0[i]; }
                }
                w0.x = cvt_pk_bf16(yv[0], yv[1]); w0.y = cvt_pk_bf16(yv[2], yv[3]); w0.z = cvt_pk_bf16(yv[4], yv[5]); w0.w = cvt_pk_bf16(yv[6], yv[7]);
                w1.x = cvt_pk_bf16(yv[8], yv[9]); w1.y = cvt_pk_bf16(yv[10], yv[11]); w1.z = cvt_pk_bf16(yv[12], yv[13]); w1.w = cvt_pk_bf16(yv[14], yv[15]);
                if (XN) { *(u32x4*)(XN + (size_t)t * D + e0) = w0; *(u32x4*)(XN + (size_t)t * D + e0 + 8) = w1; }
                if (XN8) { u32x4 w8; w8.x = pk4_fp8(yv[0], yv[1], yv[2], yv[3]); w8.y = pk4_fp8(yv[4], yv[5], yv[6], yv[7]); w8.z = pk4_fp8(yv[8], yv[9], yv[10], yv[11]); w8.w = pk4_fp8(yv[12], yv[13], yv[14], yv[15]); *(u32x4*)(XN8 + (size_t)t * D + e0) = w8; } } }
    }
}
constexpr int NPH = 13, N_PHASES = 1 + 2 * NPH;
enum { PH_NORM1 = 0, PH_QKV, PH_QKNORM, PH_ATTN, PH_DACOMB, PH_OUTPROJ, PH_NORM2, PH_ROUTER, PH_ROUTE, PH_SORT, PH_GEMM1, PH_GEMM2, PH_COMBINE };

__device__ __forceinline__ float uni_f(float x) { return __int_as_float(__builtin_amdgcn_readfirstlane(__float_as_int(x))); }
__device__ __forceinline__ void attn_phase_sb(const Frame& F, const Args& a) {
    att::AttnArgs A{(const bf16_t*)(a.ws + WS_QKV), (bf16_t*)(a.ws + WS_O), D};
    for (int u = F.bid; u < 1024; u += F.G) { const int bh = u >> 4, qq = u & 15; const int qb = ((bh >> 4) & 1) ? 15 - qq : qq; const int b = bh >> 4, h = bh & 15;
        att::attn_unit<0>(A, b, qb, h * 128, D + h * 128, 2 * D + h * 128, h * 128, 0.f, 0, (LAS char*)F.lds); }
}
__device__ __forceinline__ void attn_phase_da(const Frame& F, const Args& a) {
    const float* qn = a.in[8]; const float* kn = a.in[9];
    float gq = fmaxf(fabsf(qn[F.lane]), fabsf(qn[F.lane + 64])), gk = fmaxf(fabsf(kn[F.lane]), fabsf(kn[F.lane + 64]));
#pragma unroll
    for (int o = 1; o < 64; o <<= 1) { gq = fmaxf(gq, __shfl_xor(gq, o)); gk = fmaxf(gk, __shfl_xor(gk, o)); }
    const float zb2 = 128.f * gq * gk * 1.01f * att::QK_C;
    const float lambda_init = 0.8f - 0.6f * 0.7408182206817179f;
    unsigned* qctr = (unsigned*)(a.ws + WS_CTL) + 64;
    LAS unsigned* ubox = (LAS unsigned*)(F.lds + TAB_MISC);
    for (;;) {
        __syncthreads();
        if (F.tid == 0) ubox[0] = __hip_atomic_fetch_add(qctr, 1u, __ATOMIC_RELAXED, __HIP_MEMORY_SCOPE_AGENT);
        __syncthreads();
        const unsigned u = ubox[0];
        if (u >= 1024u) break;
        const int h = 7 - (int)(u >> 7), rem = (int)(u & 127u), qb = 31 - (rem >> 2), b = rem & 3;
        const float slope2 = exp2f(-(float)(h + 1)) * LOG2E;
        const float dm = (150.f + 2.f * zb2) / slope2; const int dmax = dm < 1.0e6f ? (int)dm + 1 : 1000000;
        const bool freeze_ok = (2.f * zb2 + 32.f * slope2) < 100.f;
        att::attn_unit_da((const bf16_t*)(a.ws + WS_QKV), (bf16_t*)(a.ws + WS_O), b, h, qb, slope2, dmax, freeze_ok, a.in, lambda_init, (LAS char*)F.lds); }
}
__device__ __forceinline__ int need_before(int p) {
    return p <= NPH ? 0 : WITEMS;
}
#define IN(k) (lo <= (k) && (k) < hi)
#ifdef PROBE_BAR2
#define SEAM(k) do { if (IN((k) + 1)) { xcd_barrier(bar); xcd_barrier(bar); } } while (0)
#else
#define SEAM(k) do { if (IN((k) + 1)) xcd_barrier(bar); } while (0)
#endif
#define PHASE(p, BODY) do { if (IN(p)) { if (!W.isw) { BODY; if (F.tid == 0) __hip_atomic_fetch_add((unsigned*)(args.ws + WS_CTL) + 1024 + 64 * (p), 1u, __ATOMIC_RELAXED, __HIP_MEMORY_SCOPE_AGENT); } \
        else worker_phase(F, args, (p), need_before((p) + 1), W.nxt, W.stride, W.nC); SEAM(p); } } while (0)
struct WorkerState { bool isw; int nxt, stride, nC; };
#define PH_BEGIN(p) if (IN(p)) { if (!W.isw) {
#define PH_END(p)   if (F.tid == 0) __hip_atomic_fetch_add((unsigned*)(args.ws + WS_CTL) + 1024 + 64 * (p), 1u, __ATOMIC_RELAXED, __HIP_MEMORY_SCOPE_AGENT); } \
                    else worker_phase(F, args, (p), need_before((p) + 1), W.nxt, W.stride, W.nC); SEAM(p); }
template <int l> __device__ __forceinline__ void layer_body(const Frame& F, const Args& args, const XcdBarrier& bar, const int lo, const int hi, WorkerState& W) {
    unsigned char* ws = args.ws;
    bf16_t* XN = (bf16_t*)(ws + WS_XN); bf16_t* QKV = (bf16_t*)(ws + WS_QKV); bf16_t* Ob = (bf16_t*)(ws + WS_O);
    bf16_t* ACT = (bf16_t*)(ws + WS_ACT); bf16_t* Y = (bf16_t*)(ws + WS_Y); bf16_t* XA = (bf16_t*)(ws + WS_XA); bf16_t* XB = (bf16_t*)(ws + WS_XB); float* logits = (float*)(ws + WS_LOGIT);
    LAS int* idx = (LAS int*)(F.lds + TAB_IDX); LAS int* tile_l = (LAS int*)(F.lds + TAB_TILE);
    const int pb = 1 + l * NPH;
    const float* modl = (const float*)(ws + WS_MOD) + (size_t)l * 4 * MODW;
    const void* xin = (l == 0) ? (const void*)args.in[0] : (const void*)XB;

#if DENSE0_QKV8
    if (l == 0) { PH_BEGIN(pb + PH_NORM1) phase_norm_x(F, (const float*)xin, args.in[4] + l * D, modl, 0, 1, ws + WS_XN8); PH_END(pb + PH_NORM1) }
#else
    if (l == 0) { PH_BEGIN(pb + PH_NORM1) phase_norm<false>(F, xin, args.in[4] + l * D, modl, 0, 1, DENSE0_QKV8 ? nullptr : XN, DENSE0_QKV8 ? ws + WS_XN8 : nullptr); PH_END(pb + PH_NORM1) }
#endif
    PH_BEGIN(pb + PH_QKV)
        pg8::StaticOrder So; So.init(T, 3 * D, F.G, F.bid);
        if (l == 0) {
#if DENSE0_QKV8
            pg8::Gemm g{(const bf16_t*)(ws + WS_XN8), (const bf16_t*)(ws + WS_WIN), D / 2, 0, nullptr, D / 2, 0}; pg8::EpiBf16 E{QKV, 3 * D, 1.f / WD_SC};
            pg8::gemm_phase<pg8::EpiBf16, pg8::StaticOrder, false, true>(F.lds, idx, g, So, E);
#else
            pg8::Gemm g{XN, (const bf16_t*)(ws + WS_WIN), D, 0, nullptr, D, 0}; pg8::EpiBf16 E{QKV, 3 * D, 1.f};
            pg8::gemm_phase<pg8::EpiBf16, pg8::StaticOrder, false>(F.lds, idx, g, So, E);
#endif
        } else {
#if DENSE1_FP8
            pg8::Gemm g{(const bf16_t*)(ws + WS_XN8), (const bf16_t*)(ws + WS_WIN8), D / 2, 0, nullptr, D / 2, 0};
            pg8::EpiBf16QK E{QKV, 3 * D, args.in[8], args.in[9], (LAS float*)(F.lds + EPI_OFF), 1.f / WD_SC};
            pg8::gemm_phase<pg8::EpiBf16QK, pg8::StaticOrder, false, true>(F.lds, idx, g, So, E);
#else
            pg8::Gemm g{XN, (const bf16_t*)(ws + WS_WIN) + (size_t)3 * D * D, D, 0, nullptr, D, 0};
            pg8::EpiBf16QK E{QKV, 3 * D, args.in[8], args.in[9], (LAS float*)(F.lds + EPI_OFF), 1.f};
            pg8::gemm_phase<pg8::EpiBf16QK, pg8::StaticOrder, false>(F.lds, idx, g, So, E);
#endif
        }
    PH_END(pb + PH_QKV)
    PH_BEGIN(pb + PH_ATTN)
        if (l == 0) attn_phase_sb(F, args); else attn_phase_da(F, args);
    PH_END(pb + PH_ATTN)
    PH_BEGIN(pb + PH_OUTPROJ)
        pg8::StaticOrder So; So.init(T, D, F.G, F.bid);
        if (l == 0) {
#if DENSE0_OUT8
            pg8::Gemm g{Ob, (const bf16_t*)(ws + WS_WOUT), D / 2, 0, nullptr, D / 2, 0}; pg8::EpiResGate<false> E{xin, XA, modl + 2 * D, 1.f / (WD_SC * O_SC)};
            pg8::gemm_phase<pg8::EpiResGate<false>, pg8::StaticOrder, false, true>(F.lds, idx, g, So, E);
#else
            pg8::Gemm g{Ob, (const bf16_t*)(ws + WS_WOUT), D, 0, nullptr, D, 0}; pg8::EpiResGate<false> E{xin, XA, modl + 2 * D, 1.f};
            pg8::gemm_phase<pg8::EpiResGate<false>, pg8::StaticOrder, false>(F.lds, idx, g, So, E);
#endif
        } else {
#if DENSE1_FP8
            pg8::Gemm g{Ob, (const bf16_t*)(ws + WS_WOUT8), D / 2, 0, nullptr, D / 2, 0}; pg8::EpiResGate<true> E{xin, XA, modl + 2 * D, 1.f / (WD_SC * O_SC)};
            pg8::gemm_phase<pg8::EpiResGate<true>, pg8::StaticOrder, false, true>(F.lds, idx, g, So, E);
#else
            pg8::Gemm g{Ob, (const bf16_t*)(ws + WS_WOUT) + (size_t)D * D, D, 0, nullptr, D, 0}; pg8::EpiResGate<true> E{xin, XA, modl + 2 * D, 1.f};
            pg8::gemm_phase<pg8::EpiResGate<true>, pg8::StaticOrder, false>(F.lds, idx, g, So, E);
#endif
        }
    PH_END(pb + PH_OUTPROJ)
#if FUSE_NRR
    PH_BEGIN(pb + PH_NORM2) phase_nrr(F, args, l, XA, args.in[5] + l * D, modl, ws + WS_XN8); PH_END(pb + PH_NORM2)
#else
    PH_BEGIN(pb + PH_NORM2) phase_norm<true>(F, XA, args.in[5] + l * D, modl, 3, 4, XN, ws + WS_XN8); PH_END(pb + PH_NORM2)
    PH_BEGIN(pb + PH_ROUTER)
        pg8::Gemm g{XN, (const bf16_t*)(ws + WS_WR) + (size_t)l * 256 * D, D / 4, (size_t)(D / 4) * 2, nullptr, D, (size_t)(D / 4) * 2}; pg8::SplitOrder So; So.init(T / 256, F.G, F.bid);
        pg8::EpiRouter E{logits};
        pg8::gemm_phase<pg8::EpiRouter, pg8::SplitOrder, false>(F.lds, idx, g, So, E);
    PH_END(pb + PH_ROUTER)
    PH_BEGIN(pb + PH_ROUTE) phase_route(F, args, l); PH_END(pb + PH_ROUTE)
#endif
    PH_BEGIN(pb + PH_SORT) phase_sort(F, args); PH_END(pb + PH_SORT)
    PH_BEGIN(pb + PH_GEMM1)
        const int* te = (const int*)(ws + WS_TILEE); const int nrt = te[NRT_MAX];
        __syncthreads();
        for (int i = F.tid; i < NRT_MAX; i += NTHREADS) tile_l[i] = (i < nrt) ? te[i] : NE;
        __syncthreads();
        pg8::Gemm g{(const bf16_t*)(ws + WS_XN8), (const bf16_t*)(ws + WS_W1 + (size_t)l * 65 * 1024 * D), D / 2, (size_t)1024 * D, (const int*)(ws + WS_TOK), D / 2, 0};
        pg8::MoeOrder Mo; Mo.init(nrt + 64, 4, F.G, F.bid, tile_l, nrt, NSR / 256);
        pg8::EpiSwiGLU8 E{(unsigned char*)ACT, 1.f / W1_SC, ACT_SC};
        pg8::gemm_phase<pg8::EpiSwiGLU8, pg8::MoeOrder, true, true>(F.lds, idx, g, Mo, E);
    PH_END(pb + PH_GEMM1)
    PH_BEGIN(pb + PH_GEMM2)
        const int* te = (const int*)(ws + WS_TILEE); const int nrt = te[NRT_MAX];
        __syncthreads();
        for (int i = F.tid; i < NRT_MAX; i += NTHREADS) tile_l[i] = (i < nrt) ? te[i] : NE;
        __syncthreads();
        pg8::Gemm g{ACT, (const bf16_t*)(ws + WS_W2 + (size_t)l * 65 * D * EF), EF / 2, (size_t)D * EF, nullptr, EF / 2, 0}; pg8::MoeOrder Mo; Mo.init(nrt + 64, 8, F.G, F.bid, tile_l, nrt, NSR / 256);
        static_assert(Y_SC / (W2_SC * ACT_SC) == 0.0625f && pg8::EpiFp8::SEXP == -4, "GEMM2 output scale is folded into the MFMA block scale");
        pg8::EpiFp8 E{(unsigned char*)Y, D, Y_SC / (W2_SC * ACT_SC)};
        pg8::gemm_phase<pg8::EpiFp8, pg8::MoeOrder, false, true>(F.lds, idx, g, Mo, E);
    PH_END(pb + PH_GEMM2)
    PH_BEGIN(pb + PH_COMBINE)
        if (l == 1) phase_combine_out(F, args, XA, modl, args.out); else
        phase_combine(F, args, XA, modl, l == 0 ? nullptr : args.out, l == 0 ? XB : nullptr, l == 0 ? args.in[4] + D : nullptr, (const float*)(ws + WS_MOD) + (size_t)4 * MODW, DENSE1_FP8 ? nullptr : XN, (l == 0 && DENSE1_FP8) ? ws + WS_XN8 : nullptr);
    PH_END(pb + PH_COMBINE)
}
__global__ void __launch_bounds__(NTHREADS, 2) mega_fwd(Args args) {
    extern __shared__ __attribute__((aligned(16))) unsigned char lds_raw[];
    Frame F; F.lds = (LAS unsigned char*)lds_raw; F.tid = threadIdx.x; F.lane = F.tid & 63; F.wave = __builtin_amdgcn_readfirstlane(F.tid >> 6);
    F.bid = blockIdx.x; F.G = gridDim.x; F.gw = F.bid * NWAVES + F.wave; F.NGW = F.G * NWAVES;
    volatile LAS unsigned* MISC = (volatile LAS unsigned*)(F.lds + MISC_OFF);
    if (F.tid < 32) MISC[F.tid] = 0u;
    if (F.tid == 0) *(volatile LAS int*)(F.lds + TAB_MISC + 512) = 0;
    __syncthreads();
    unsigned char* ws = args.ws;
    unsigned* ctl = (unsigned*)(ws + WS_CTL);
    const int lo = args.ph_lo, hi = args.ph_hi;
    const bool multi = (hi - lo) > 1;
    unsigned* barw = ctl + CW_BAR + args.li * XCD_BAR_WORDS;
    XcdBarrier bar; bar.bar = barw; bar.x = 0; bar.st = nullptr;
    if (multi) bar = xcd_barrier_post(barw, MISC + 8);
    if (IN(0)) { p0_prologue(F, args); SEAM(0); }
    WorkerState W; W.nC = (int)gridDim.x - NWORK; W.isw = (int)blockIdx.x >= W.nC; W.stride = NWORK * NWAVES;
    { const int ww = ((int)blockIdx.x - W.nC) * NWAVES + F.wave, base = need_before(lo > 1 ? lo : 1); W.nxt = base + (((ww - base) % W.stride) + W.stride) % W.stride; }
    F.G = W.nC; F.NGW = W.nC * NWAVES;
    layer_body<0>(F, args, bar, lo, hi, W);
    W.isw = false; W.nC = (int)gridDim.x; F.G = (int)gridDim.x; F.NGW = F.G * NWAVES;
    layer_body<1>(F, args, bar, lo, hi, W);
}
#undef PH_BEGIN
#undef PH_END
#ifndef FAST_DENSE
#define FAST_DENSE 1
#endif
#ifndef FAST_MOE
#define FAST_MOE 1
#endif
#ifndef FAST_SB
#define FAST_SB 1
#endif
#ifndef FAST_DA
#define FAST_DA 1
#endif
#ifndef ONE_LAUNCH
#define ONE_LAUNCH 1
#endif
#define NEED_NAIVE (!(FAST_DENSE && FAST_MOE && FAST_SB && FAST_DA))
#if NEED_NAIVE
__device__ __forceinline__ float bf2f(bf16_t v) { return __uint_as_float((unsigned)v << 16); }
__device__ __forceinline__ bf16_t f2bf(float f) { return (bf16_t)(cvt_pk_bf16(f, 0.f) & 0xffffu); }
__device__ __forceinline__ float silu_f(float v) { return v / (1.f + expf(-v)); }
__device__ __forceinline__ float softplus_f(float z) { return fmaxf(z, 0.f) + log1pf(expf(-fabsf(z))); }
struct NG { const bf16_t* A; const float* Bm; const float* Bs; const float* B2m; const float* B2s; void* C; int M, N, K, lda, ldb, ldc; const int* arow; const int* tile_e; long bstride; const float* R; const float* gate; };
template <int EPI> __global__ __launch_bounds__(256) void k_ngemm(NG p) {
    __shared__ float As[16][68]; __shared__ float Bs[16][68]; __shared__ float Cs[16][68];
    const int m0 = blockIdx.y * 64, n0 = blockIdx.x * 64, tid = threadIdx.x, tx = tid & 15, ty = tid >> 4;
    const float* Bm = p.Bm; const float* B2 = p.B2m;
    if (p.tile_e) { const int rt = m0 >> 8; const int e = (rt >= NSR / 256) ? NE : ((rt < p.tile_e[NRT_MAX]) ? p.tile_e[rt] : -1); if (e < 0) return;
        if (e == NE) { Bm = p.Bs; B2 = p.B2s; } else { Bm += (size_t)e * p.bstride; if (EPI == 3) B2 += (size_t)e * p.bstride; } }
    const int ar = tid >> 2, ak = (tid & 3) * 4; const int arow = p.arow ? p.arow[m0 + ar] : (m0 + ar);
    const bf16_t* Ap = p.A + (size_t)arow * p.lda + ak;
    const int bk = tid >> 4, bn = (tid & 15) * 4; const size_t boff = (size_t)bk * p.ldb + n0 + bn;
    float acc[4][4] = {}, acc2[4][4] = {};
    for (int k0 = 0; k0 < p.K; k0 += 16) {
        const u32x2 a = *(const u32x2*)(Ap + k0); const float4 b = *(const float4*)(Bm + boff + (size_t)k0 * p.ldb);
        float4 c2 = make_float4(0, 0, 0, 0); if (EPI == 3) c2 = *(const float4*)(B2 + boff + (size_t)k0 * p.ldb);
        __syncthreads();
        As[ak + 0][ar] = bf_lo(a.x); As[ak + 1][ar] = bf_hi(a.x); As[ak + 2][ar] = bf_lo(a.y); As[ak + 3][ar] = bf_hi(a.y);
        *(float4*)&Bs[bk][bn] = b; if (EPI == 3) *(float4*)&Cs[bk][bn] = c2;
        __syncthreads();
#pragma unroll
        for (int k = 0; k < 16; ++k) { const float4 av = *(const float4*)&As[k][ty * 4]; const float4 bv = *(const float4*)&Bs[k][tx * 4];
            const float aa[4] = {av.x, av.y, av.z, av.w}, bb[4] = {bv.x, bv.y, bv.z, bv.w};
#pragma unroll
            for (int i = 0; i < 4; ++i)
#pragma unroll
                for (int j = 0; j < 4; ++j) acc[i][j] += aa[i] * bb[j];
            if (EPI == 3) { const float4 cv = *(const float4*)&Cs[k][tx * 4]; const float cc[4] = {cv.x, cv.y, cv.z, cv.w};
#pragma unroll
                for (int i = 0; i < 4; ++i)
#pragma unroll
                    for (int j = 0; j < 4; ++j) acc2[i][j] += aa[i] * cc[j]; } }
    }
#pragma unroll
    for (int i = 0; i < 4; ++i) { const int m = m0 + ty * 4 + i; const int n = n0 + tx * 4;
        if (EPI == 1) { const float4 r = *(const float4*)(p.R + (size_t)m * p.ldc + n); const float4 g = *(const float4*)(p.gate + (size_t)(m / S) * MODW + n);
            *(float4*)((float*)p.C + (size_t)m * p.ldc + n) = make_float4(r.x + g.x * acc[i][0], r.y + g.y * acc[i][1], r.z + g.z * acc[i][2], r.w + g.w * acc[i][3]); }
        else { float v[4];
#pragma unroll
            for (int j = 0; j < 4; ++j) v[j] = (EPI == 3) ? silu_f(acc[i][j]) * acc2[i][j] : acc[i][j];
            u32x2 o; o.x = cvt_pk_bf16(v[0], v[1]); o.y = cvt_pk_bf16(v[2], v[3]); *(u32x2*)((bf16_t*)p.C + (size_t)m * p.ldc + n) = o; } }
}
__global__ void k_nlogits(const bf16_t* __restrict__ XN, const float* __restrict__ w_router, float* __restrict__ logits) {
    const int t = (blockIdx.x * 256 + threadIdx.x) >> 6, lane = threadIdx.x & 63;
    const bf16_t* hr = XN + (size_t)t * D; const float* wr = w_router + (size_t)lane * D; float acc = 0.f;
    for (int k = 0; k < D; k += 4) { const u32x2 a = *(const u32x2*)(hr + k); const float4 w = *(const float4*)(wr + k); acc += bf_lo(a.x) * w.x + bf_hi(a.x) * w.y + bf_lo(a.y) * w.z + bf_hi(a.y) * w.w; }
    logits[(size_t)t * NE + lane] = acc;
}
template <int MODE, int DV>
__global__ __launch_bounds__(256) void k_nattn(const bf16_t* __restrict__ qkv, bf16_t* __restrict__ outb) {
    extern __shared__ float sm[];
    float* Qs = sm; float* Ks = Qs + 64 * 129; float* Vs = Ks + 64 * 129; float* Z = Vs + 64 * DV; float* al = Z + 64 * 65;
    const int qt = blockIdx.x, vh = blockIdx.y, b = blockIdx.z, tid = threadIdx.x, tx = tid & 15, ty = tid >> 4;
    int qcol, kcol, vcol, ocol; float slope = 0.f; bf16_t* out = outb;
    if (MODE == 0) { qcol = vh * 128; kcol = D + vh * 128; vcol = 2 * D + vh * 128; ocol = vh * 128; }
    else { const int h = vh >> 1; qcol = vh * 128; kcol = D + vh * 128; vcol = 2 * D + h * 256; ocol = h * 256; out += (size_t)(vh & 1) * T * D; slope = exp2f(-(float)(h + 1)); }
    const float scale = 0.08838834764831845f; const size_t rowb = (size_t)b * S;
    for (int i = tid; i < 64 * 128; i += 256) { const int r = i >> 7, d = i & 127; Qs[r * 129 + d] = bf2f(qkv[(rowb + qt * 64 + r) * (3 * D) + qcol + d]); }
    constexpr int NC = DV / 16; float acc[4][NC];
#pragma unroll
    for (int i = 0; i < 4; ++i)
#pragma unroll
        for (int c = 0; c < NC; ++c) acc[i][c] = 0.f;
    float carry = 0.f, mrow = -1e30f, lrow = 0.f;
    for (int kt = qt; kt >= 0; --kt) {
        __syncthreads();
        for (int i = tid; i < 64 * 128; i += 256) { const int r = i >> 7, d = i & 127; Ks[r * 129 + d] = bf2f(qkv[(rowb + kt * 64 + r) * (3 * D) + kcol + d]); }
        for (int i = tid; i < 64 * DV; i += 256) { const int r = i / DV, d = i % DV; Vs[r * DV + d] = bf2f(qkv[(rowb + kt * 64 + r) * (3 * D) + vcol + d]); }
        __syncthreads();
        float z[4][4] = {};
        for (int d = 0; d < 128; ++d) { float qa[4], kb[4];
#pragma unroll
            for (int i = 0; i < 4; ++i) { qa[i] = Qs[(ty * 4 + i) * 129 + d]; kb[i] = Ks[(tx * 4 + i) * 129 + d]; }
#pragma unroll
            for (int i = 0; i < 4; ++i)
#pragma unroll
                for (int j = 0; j < 4; ++j) z[i][j] += qa[i] * kb[j]; }
#pragma unroll
        for (int i = 0; i < 4; ++i)
#pragma unroll
            for (int j = 0; j < 4; ++j) Z[(ty * 4 + i) * 65 + tx * 4 + j] = z[i][j] * scale;
        __syncthreads();
        if (tid < 64) { const int tq = qt * 64 + tid; float* zr = Z + tid * 65;
            if (MODE == 0) {
                for (int j = 63; j >= 0; --j) { const int sk = kt * 64 + j; float a = 0.f; if (sk < tq) { const float zz = zr[j], sp = softplus_f(zz); a = expf(zz - sp + carry); carry -= sp; } zr[j] = a; }
                al[tid] = 1.f;
            } else { float mx = -1e30f;
                for (int j = 0; j < 64; ++j) { const int sk = kt * 64 + j; if (sk <= tq) { const float zz = zr[j] - slope * (float)(tq - sk); zr[j] = zz; mx = fmaxf(mx, zz); } }
                const float mn = fmaxf(mrow, mx), alpha = expf(mrow - mn); float ps = 0.f;
                for (int j = 0; j < 64; ++j) { const int sk = kt * 64 + j; float pv = 0.f; if (sk <= tq) { pv = expf(zr[j] - mn); ps += pv; } zr[j] = pv; }
                lrow = lrow * alpha + ps; mrow = mn; al[tid] = alpha; } }
        __syncthreads();
#pragma unroll
        for (int i = 0; i < 4; ++i) { const float a_ = al[ty * 4 + i];
#pragma unroll
            for (int c = 0; c < NC; ++c) acc[i][c] *= a_; }
        for (int j = 0; j < 64; ++j) { float pa[4];
#pragma unroll
            for (int i = 0; i < 4; ++i) pa[i] = Z[(ty * 4 + i) * 65 + j];
#pragma unroll
            for (int c = 0; c < NC; ++c) { const float vv = Vs[j * DV + tx + 16 * c];
#pragma unroll
                for (int i = 0; i < 4; ++i) acc[i][c] += pa[i] * vv; } }
    }
    __syncthreads();
    if (tid < 64) al[tid] = (MODE == 1) ? 1.f / lrow : 1.f;
    __syncthreads();
#pragma unroll
    for (int i = 0; i < 4; ++i) { const float a_ = al[ty * 4 + i];
#pragma unroll
        for (int c = 0; c < NC; ++c) out[(rowb + qt * 64 + ty * 4 + i) * D + ocol + tx + 16 * c] = f2bf(acc[i][c] * a_); }
}
#endif

static bool phase_is_fast(int p) {
    if (p == 0) return true; const int k = (p - 1) % NPH, l = (p - 1) / NPH;
    if (k == PH_QKV || k == PH_OUTPROJ) return FAST_DENSE;
    if (k == PH_ROUTER || k == PH_GEMM1 || k == PH_GEMM2) return FAST_MOE;
    if (k == PH_ATTN) return l == 0 ? FAST_SB : FAST_DA;
    return true;
}

extern "C" void kernel_launch(void* const* d_in, const int* in_sizes, int n_in, void* d_out, int out_size, void* d_ws, size_t ws_size, hipStream_t stream) {
    static int grid = 0;
    if (grid == 0) {
        if (n_in != 23 || in_sizes[0] != T * D || out_size != T * D || ws_size < WS_END) { fprintf(stderr, "kernel_launch: unexpected shapes (n_in %d in0 %d out %d ws %zu, need ws >= %zu)\n", n_in, n_in > 0 ? in_sizes[0] : -1, out_size, ws_size, (size_t)WS_END); grid = -1; return; }
        int dev = 0, cus = 0, per_cu = 0;
        if (hipGetDevice(&dev) != hipSuccess || hipDeviceGetAttribute(&cus, hipDeviceAttributeMultiprocessorCount, dev) != hipSuccess) { grid = -1; return; }
        if (hipFuncSetAttribute((const void*)mega_fwd, hipFuncAttributeMaxDynamicSharedMemorySize, LDS_BYTES) != hipSuccess) { fprintf(stderr, "kernel_launch: hipFuncSetAttribute failed\n"); grid = -1; return; }
        if (hipOccupancyMaxActiveBlocksPerMultiprocessor(&per_cu, (const void*)mega_fwd, NTHREADS, LDS_BYTES) != hipSuccess || per_cu < 1) fprintf(stderr, "kernel_launch: occupancy query says %d\n", per_cu);
        (void)hipGetLastError();
        grid = cus;
        if (grid > 256) grid = 256;
#if NEED_NAIVE
        (void)hipFuncSetAttribute((const void*)k_nattn<0, 128>, hipFuncAttributeMaxDynamicSharedMemorySize, (64 * 129 * 2 + 64 * 128 + 64 * 65 + 64) * 4);
        (void)hipFuncSetAttribute((const void*)k_nattn<1, 256>, hipFuncAttributeMaxDynamicSharedMemorySize, (64 * 129 * 2 + 64 * 256 + 64 * 65 + 64) * 4);
#endif
    }
    if (grid < 0) return;
    if (hipMemsetAsync((char*)d_ws + WS_CTL, 0, ZERO_BYTES, stream) != hipSuccess) { fprintf(stderr, "kernel_launch: memset failed\n"); return; }
    Args a{};
    for (int i = 0; i < 23; ++i) a.in[i] = (const float*)d_in[i];
    a.out = (float*)d_out; a.ws = (unsigned char*)d_ws;
    unsigned char* ws = (unsigned char*)d_ws;
    int lo = 0, nl = 0;
    auto flush = [&](int hi) { if (hi > lo) {
#if ONE_LAUNCH
            a.ph_lo = lo; a.ph_hi = hi; a.li = nl++; hipLaunchKernelGGL(mega_fwd, dim3(grid), dim3(NTHREADS), LDS_BYTES, stream, a);
#else
            for (int p = lo; p < hi; ++p) { a.ph_lo = p; a.ph_hi = p + 1; hipLaunchKernelGGL(mega_fwd, dim3(grid), dim3(NTHREADS), LDS_BYTES, stream, a);
#ifdef REPEAT_MASK
                if ((REPEAT_MASK >> p) & 1ull) { (void)hipMemsetAsync((char*)d_ws + WS_CTL + 256, 0, 4, stream);
                    hipLaunchKernelGGL(mega_fwd, dim3(grid), dim3(NTHREADS), LDS_BYTES, stream, a); }
#endif
            }
#endif
        } };
    for (int p = 0; p < N_PHASES; ++p) {
        if (phase_is_fast(p)) continue;
        flush(p); lo = p + 1;
#if NEED_NAIVE
        const int k = (p - 1) % NPH, l = (p - 1) / NPH;
        const float* modl = (const float*)(ws + WS_MOD) + (size_t)l * 4 * MODW; const float* xin = (l == 0) ? a.in[0] : a.out;
        bf16_t* XN = (bf16_t*)(ws + WS_XN); bf16_t* QKV = (bf16_t*)(ws + WS_QKV); bf16_t* Ob = (bf16_t*)(ws + WS_O); bf16_t* OT = (bf16_t*)(ws + WS_OT);
        bf16_t* ACT = (bf16_t*)(ws + WS_ACT); bf16_t* Y = (bf16_t*)(ws + WS_Y); float* XA = (float*)(ws + WS_XA);
        NG g{};
        if (k == PH_QKV) { g.A = XN; g.Bm = a.in[6] + (size_t)l * D * 3 * D; g.C = QKV; g.M = T; g.N = 3 * D; g.K = D; g.lda = D; g.ldb = 3 * D; g.ldc = 3 * D;
            hipLaunchKernelGGL(k_ngemm<0>, dim3(g.N / 64, g.M / 64), dim3(256), 0, stream, g); }
        else if (k == PH_OUTPROJ) { g.A = Ob; g.Bm = a.in[7] + (size_t)l * D * D; g.C = XA; g.M = T; g.N = D; g.K = D; g.lda = D; g.ldb = D; g.ldc = D; g.R = xin; g.gate = modl + 2 * D;
            hipLaunchKernelGGL(k_ngemm<1>, dim3(g.N / 64, g.M / 64), dim3(256), 0, stream, g); }
        else if (k == PH_ROUTER) { hipLaunchKernelGGL(k_nlogits, dim3(T / 4), dim3(256), 0, stream, XN, a.in[15] + (size_t)l * NE * D, (float*)(ws + WS_LOGIT)); }
        else if (k == PH_GEMM1) { g.A = XN; g.Bm = a.in[17] + (size_t)l * NE * D * EF; g.Bs = a.in[20] + (size_t)l * D * EF; g.B2m = a.in[18] + (size_t)l * NE * D * EF; g.B2s = a.in[21] + (size_t)l * D * EF;
            g.C = ACT; g.M = NS; g.N = EF; g.K = D; g.lda = D; g.ldb = EF; g.ldc = EF; g.arow = (const int*)(ws + WS_TOK); g.tile_e = (const int*)(ws + WS_TILEE); g.bstride = (long)D * EF;
            hipLaunchKernelGGL(k_ngemm<3>, dim3(g.N / 64, g.M / 64), dim3(256), 0, stream, g); }
        else if (k == PH_GEMM2) { g.A = ACT; g.Bm = a.in[19] + (size_t)l * NE * EF * D; g.Bs = a.in[22] + (size_t)l * EF * D; g.C = Y; g.M = NS; g.N = D; g.K = EF; g.lda = EF; g.ldb = D; g.ldc = D;
            g.tile_e = (const int*)(ws + WS_TILEE); g.bstride = (long)EF * D;
            hipLaunchKernelGGL(k_ngemm<0>, dim3(g.N / 64, g.M / 64), dim3(256), 0, stream, g); }
        else if (k == PH_ATTN) {
            if (l == 0) hipLaunchKernelGGL((k_nattn<0, 128>), dim3(S / 64, 16, NB), dim3(256), (64 * 129 * 2 + 64 * 128 + 64 * 65 + 64) * 4, stream, QKV, Ob);
            else hipLaunchKernelGGL((k_nattn<1, 256>), dim3(S / 64, 16, NB), dim3(256), (64 * 129 * 2 + 64 * 256 + 64 * 65 + 64) * 4, stream, QKV, OT); }
#endif
    }
    flush(N_PHASES);
    const hipError_t le = hipPeekAtLastError();
    if (le != hipSuccess) fprintf(stderr, "kernel_launch: launch failed: %s\n", hipGetErrorName(le));
}
```
